# Optimizing an MI355X kernel written in HIP

```python
import jax, jax.numpy as jnp
from jax import lax
import numpy as np

D_MODEL = 1024
BATCH = 8
SEQ = 4096
DEPTH = 1

PLE_DIM = 256
N_ATTN_HEADS = 8
HEAD_DIM = 64
ATTN_WIDTH = N_ATTN_HEADS * HEAD_DIM
SSD_HEADS = 8
SSD_HEAD_DIM = 64
SSD_WIDTH = SSD_HEADS * SSD_HEAD_DIM
SSD_STATE = 128
CONV_WIDTH = 4
CONV_CH = SSD_WIDTH + 2 * SSD_STATE
CHUNK = 128
MIX_WIDTH = ATTN_WIDTH + SSD_WIDTH
IN_PROJ_WIDTH = 3 * ATTN_WIDTH + SSD_WIDTH + CONV_CH + SSD_HEADS
D_FF = 4 * D_MODEL
ROPE_THETA = 10000.0
DILATED_BRANCHES = ((128, 1), (512, 4), (2048, 16))
ATTN_BLOCK = 128
NORM_EPS = 1e-6

kernel_name = 'hybrid_ssd_dilated_attention_layer'


def rms_norm(x, g):
    xf = x.astype(jnp.float32)
    xf = xf * lax.rsqrt(jnp.mean(xf * xf, axis=-1, keepdims=True) + NORM_EPS)
    return xf.astype(x.dtype) * g


def apply_rope(t, positions):
    dh = t.shape[-1]
    half = dh // 2
    inv_freq = ROPE_THETA ** (-jnp.arange(half, dtype=jnp.float32) * 2.0 / dh)
    ang = positions.astype(jnp.float32)[:, :, None] * inv_freq
    cos = jnp.cos(ang)[:, :, None, :]
    sin = jnp.sin(ang)[:, :, None, :]
    tf = t.astype(jnp.float32)
    t1, t2 = tf[..., :half], tf[..., half:]
    return jnp.concatenate([t1 * cos - t2 * sin, t2 * cos + t1 * sin], axis=-1).astype(t.dtype)


def dilated_branch(q, k, v, window, dilation):
    b, s, nh, dh = q.shape
    span = window // dilation
    blk = ATTN_BLOCK
    sub_len = s // dilation
    nb = -(-sub_len // blk)
    sub_pad = nb * blk

    def to_sub(t):
        t = t.reshape(b, sub_len, dilation, nh, dh).transpose(0, 2, 1, 3, 4)
        return jnp.pad(t, ((0, 0), (0, 0), (0, sub_pad - sub_len), (0, 0), (0, 0)))

    def band(t):
        t = jnp.pad(t, ((0, 0), (0, 0), (blk, 0), (0, 0), (0, 0)))
        t = t.reshape(b, dilation, nb + 1, blk, nh, dh)
        return jnp.concatenate([t[:, :, :-1], t[:, :, 1:]], axis=3)

    qb = to_sub(q).reshape(b, dilation, nb, blk, nh, dh)
    kb = band(to_sub(k))
    vb = band(to_sub(v))

    scores = jnp.einsum('brnqhd,brnkhd->brnhqk', qb, kb).astype(jnp.float32)
    qi = jnp.arange(blk)[:, None]
    ki = jnp.arange(2 * blk)[None, :]
    dist = qi + blk - ki
    key_idx = jnp.arange(nb)[:, None, None] * blk - blk + ki
    valid = (dist >= 0) & (dist <= span) & (key_idx >= 0)
    scores = jnp.where(valid[None, None, :, None], scores, -jnp.inf)
    m = jnp.max(scores, axis=-1, keepdims=True)
    e = jnp.exp(scores - m)
    den = jnp.sum(e, axis=-1, keepdims=True)
    out = jnp.einsum('brnhqk,brnkhd->brnqhd', (e / den).astype(v.dtype), vb)
    lse = (m + jnp.log(den))[..., 0]

    out = out.reshape(b, dilation, sub_pad, nh, dh)[:, :, :sub_len]
    out = out.transpose(0, 2, 1, 3, 4).reshape(b, s, nh, dh)
    lse = lse.transpose(0, 1, 2, 4, 3).reshape(b, dilation, sub_pad, nh)[:, :, :sub_len]
    lse = lse.transpose(0, 2, 1, 3).reshape(b, s, nh)
    return out, lse


def causal_conv(u, w, bias):
    y = lax.conv_general_dilated(u, w[:, None, :], window_strides=(1,),
                                 padding=[(CONV_WIDTH - 1, 0)],
                                 dimension_numbers=('NWC', 'WIO', 'NWC'),
                                 feature_group_count=u.shape[-1])
    return y + bias


def segsum_exp(a):
    t = a.shape[-1]
    cs = jnp.cumsum(a, axis=-1)
    diff = cs[..., :, None] - cs[..., None, :]
    mask = jnp.tril(jnp.ones((t, t), dtype=bool))
    return jnp.exp(jnp.where(mask, diff, -jnp.inf))


def ssd_chunked(xdt, adt, bm, cm):
    b, s, nh, hp = xdt.shape
    n = bm.shape[-1]
    c = s // CHUNK
    x_c = xdt.reshape(b, c, CHUNK, nh, hp)
    a_c = adt.reshape(b, c, CHUNK, nh).transpose(0, 3, 1, 2)
    b_c = bm.reshape(b, c, CHUNK, n)
    c_c = cm.reshape(b, c, CHUNK, n)
    a_cs = jnp.cumsum(a_c, axis=-1)

    decay = segsum_exp(a_c)
    cb = jnp.einsum('bcln,bcsn->bcls', c_c, b_c)
    y_diag = jnp.einsum('bcls,bhcls,bcshp->bclhp', cb, decay, x_c)

    decay_states = jnp.exp(a_cs[..., -1:] - a_cs)
    states = jnp.einsum('bcln,bhcl,bclhp->bchpn', b_c, decay_states, x_c)
    chunk_decay = jnp.exp(a_cs[..., -1])

    def step(carry, inp):
        st, dec = inp
        return carry * dec[..., None, None] + st, carry

    init = jnp.zeros_like(states[:, 0])
    _, prev = lax.scan(step, init, (states.transpose(1, 0, 2, 3, 4), chunk_decay.transpose(2, 0, 1)))
    prev = prev.transpose(1, 0, 2, 3, 4)
    y_off = jnp.einsum('bcln,bchpn,bhcl->bclhp', c_c, prev, jnp.exp(a_cs))
    return (y_diag + y_off).reshape(b, s, nh, hp)


def hybrid_mixer(u, positions, w_in, conv_w, conv_b, dt_bias, a_log, d_skip, ssd_norm_g, w_out):
    b, s, _ = u.shape
    proj = u @ w_in
    splits = [ATTN_WIDTH, 2 * ATTN_WIDTH, 3 * ATTN_WIDTH,
              3 * ATTN_WIDTH + SSD_WIDTH, 3 * ATTN_WIDTH + SSD_WIDTH + CONV_CH]
    q, k, v, z, xbc, dt = jnp.split(proj, splits, axis=-1)

    q = apply_rope(q.reshape(b, s, N_ATTN_HEADS, HEAD_DIM), positions) * (HEAD_DIM ** -0.5)
    k = apply_rope(k.reshape(b, s, N_ATTN_HEADS, HEAD_DIM), positions)
    v = v.reshape(b, s, N_ATTN_HEADS, HEAD_DIM)
    outs, lses = [], []
    for window, dilation in DILATED_BRANCHES:
        o, l = dilated_branch(q, k, v, window, dilation)
        outs.append(o)
        lses.append(l)
    alpha = jax.nn.softmax(jnp.stack(lses, axis=0), axis=0)
    attn = jnp.einsum('absh,abshd->bshd', alpha, jnp.stack(outs, axis=0).astype(jnp.float32))
    attn = attn.reshape(b, s, ATTN_WIDTH).astype(u.dtype)

    xbc = jax.nn.silu(causal_conv(xbc, conv_w, conv_b))
    xs, bm, cm = jnp.split(xbc, [SSD_WIDTH, SSD_WIDTH + SSD_STATE], axis=-1)
    xs = xs.reshape(b, s, SSD_HEADS, SSD_HEAD_DIM).astype(jnp.float32)
    dt = jax.nn.softplus(dt.astype(jnp.float32) + dt_bias)
    a = -jnp.exp(a_log.astype(jnp.float32))
    y = ssd_chunked(xs * dt[..., None], dt * a, bm.astype(jnp.float32), cm.astype(jnp.float32))
    y = y + d_skip[:, None] * xs
    y = rms_norm(y.reshape(b, s, SSD_WIDTH) * jax.nn.silu(z.astype(jnp.float32)), ssd_norm_g)
    y = y.astype(u.dtype)

    return jnp.concatenate([attn, y], axis=-1) @ w_out


def setup_inputs(seed: int = 0) -> dict:
    key = jax.random.key(seed)
    ks = jax.random.split(key, 24)
    f32 = jnp.float32

    def gain(k, n):
        return 1.0 + 0.01 * jax.random.normal(k, (DEPTH, n), f32)

    x = jax.random.normal(ks[0], (BATCH, SEQ, D_MODEL), f32)
    p = jax.random.normal(ks[1], (DEPTH, BATCH, SEQ, PLE_DIM), f32)
    offset = jax.random.randint(ks[2], (BATCH, 1), 0, 1024, dtype=jnp.int32)
    positions = (jnp.arange(SEQ, dtype=jnp.int32)[None, :] + offset).astype(jnp.int32)

    w_in = jax.random.normal(ks[3], (DEPTH, D_MODEL, IN_PROJ_WIDTH), f32) * D_MODEL ** -0.5
    conv_w = jax.random.normal(ks[4], (DEPTH, CONV_WIDTH, CONV_CH), f32) * CONV_WIDTH ** -0.5
    conv_b = 0.01 * jax.random.normal(ks[5], (DEPTH, CONV_CH), f32)
    dt0 = jnp.exp(jax.random.uniform(ks[6], (DEPTH, SSD_HEADS), f32, np.log(1e-3), np.log(1e-1)))
    dt_bias = dt0 + jnp.log(-jnp.expm1(-dt0))
    a_log = jnp.log(jax.random.uniform(ks[7], (DEPTH, SSD_HEADS), f32, 1.0, 16.0))
    d_skip = 1.0 + 0.01 * jax.random.normal(ks[8], (DEPTH, SSD_HEADS), f32)
    w_out = jax.random.normal(ks[9], (DEPTH, MIX_WIDTH, D_MODEL), f32) * MIX_WIDTH ** -0.5
    w_up = jax.random.normal(ks[10], (DEPTH, D_MODEL, D_FF), f32) * D_MODEL ** -0.5
    w_down = jax.random.normal(ks[11], (DEPTH, D_FF, D_MODEL), f32) * D_FF ** -0.5
    w_ple_gate = jax.random.normal(ks[12], (DEPTH, D_MODEL, D_MODEL), f32) * D_MODEL ** -0.5
    w_ple_proj = jax.random.normal(ks[13], (DEPTH, PLE_DIM, D_MODEL), f32) * PLE_DIM ** -0.5

    return {
        'x': x, 'p': p, 'positions': positions,
        'norm_mix_pre': gain(ks[14], D_MODEL), 'norm_mix_post': gain(ks[15], D_MODEL),
        'w_in': w_in, 'conv_w': conv_w, 'conv_b': conv_b, 'dt_bias': dt_bias,
        'a_log': a_log, 'd_skip': d_skip, 'ssd_norm_g': gain(ks[16], SSD_WIDTH),
        'w_out': w_out,
        'norm_mlp_pre': gain(ks[17], D_MODEL), 'norm_mlp_post': gain(ks[18], D_MODEL),
        'w_up': w_up, 'w_down': w_down,
        'w_ple_gate': w_ple_gate, 'w_ple_proj': w_ple_proj,
        'norm_ple_post': gain(ks[19], D_MODEL),
    }


def reference(x, p, positions, norm_mix_pre, norm_mix_post, w_in, conv_w, conv_b, dt_bias,
              a_log, d_skip, ssd_norm_g, w_out, norm_mlp_pre, norm_mlp_post, w_up, w_down,
              w_ple_gate, w_ple_proj, norm_ple_post):
    h = x
    for i in range(DEPTH):
        u = rms_norm(h, norm_mix_pre[i])
        mix = hybrid_mixer(u, positions, w_in[i], conv_w[i], conv_b[i], dt_bias[i], a_log[i],
                           d_skip[i], ssd_norm_g[i], w_out[i])
        h = h + rms_norm(mix, norm_mix_post[i])
        u = rms_norm(h, norm_mlp_pre[i])
        ff = jnp.square(jax.nn.relu(u @ w_up[i])) @ w_down[i]
        h = h + rms_norm(ff, norm_mlp_post[i])
        ple = (p[i] @ w_ple_proj[i]) * jax.nn.sigmoid(h @ w_ple_gate[i])
        h = h + rms_norm(ple, norm_ple_post[i])
    return h
```

```cpp
#include <hip/hip_bf16.h>
#include <cmath>
#include <hip/hip_runtime.h>
#include <cstdio>
#include <cstdint>
namespace pg8 {
#define PG8_LAS __attribute__((address_space(3)))
typedef unsigned short bf16_t;
typedef short bf16x8 __attribute__((ext_vector_type(8)));
typedef float f32x4 __attribute__((ext_vector_type(4)));
typedef unsigned u32x4 __attribute__((ext_vector_type(4)));
constexpr int BM = 256, BK = 64, HALF = 128, HTB = HALF * BK * 2  , STAGE_BYTES = 8 * HTB, NXCD = 8, WGM = 8;

__host__ __device__ __forceinline__ int lds_byte(int r, int c) { const int st = (r >> 4) * 2 + (c >> 5), rr = r & 15, cc = c & 31, ob = rr * 64 + cc * 2; return st * 1024 + (ob ^ (((ob >> 9) & 1) << 5)); }
__host__ __device__ __forceinline__ void stage_rc(int b, int& R, int& C) { const int st = b / 1024, sb = b % 1024, swz = sb ^ (((sb >> 9) & 1) << 5); R = (st >> 1) * 16 + swz / 64; C = (st & 1) * 32 + (swz % 64) / 2; }
__host__ __device__ __forceinline__ int perm32(int rho) { const int n = rho >> 4, i = rho & 15; return 8 * (i >> 2) + 4 * n + (i & 3); }

struct Unit { int pm, pn; };
struct Gemm { const bf16_t* A; const bf16_t* Bt; int M, N, K; };

struct StaticOrder {
    int nM, nN, nwg, G, c;
    __host__ __device__ void init(int M, int N, int G_, int c_) { nM = M / BM; nN = N / BM; nwg = nM * nN; G = G_; c = c_; }
    __host__ __device__ bool next(int i, Unit& u) const {
        const long L = (long)i * G + c; if (L >= nwg) return false;
        int wgid = (int)L; { const int q = nwg / NXCD, r = nwg % NXCD, xcd = wgid % NXCD, off = wgid / NXCD; wgid = (xcd < r ? xcd * (q + 1) : r * (q + 1) + (xcd - r) * q) + off; }
        const int nig = WGM * nN, gid = wgid / nig, fm = gid * WGM, gsz = (nM - fm) < WGM ? (nM - fm) : WGM;
        u.pm = fm + ((wgid % nig) % gsz); u.pn = (wgid % nig) / gsz; return true;
    }
    __device__ __forceinline__ void a_ready(const Unit&) const {}
    __device__ __forceinline__ void done(const Unit&) const {}
};


typedef float f32x2 __attribute__((ext_vector_type(2))); typedef __bf16 bf16x2_t __attribute__((ext_vector_type(2)));
__device__ __forceinline__ unsigned cvt_pk_bf16(float lo, float hi) { const f32x2 v = {lo, hi}; const bf16x2_t b = __builtin_convertvector(v, bf16x2_t); return __builtin_bit_cast(unsigned, b); }

__device__ __forceinline__ float act_apply(int ACT, float v) {
    if (ACT == 2) { const float r = v > 0.f ? v : 0.f; return r * r; }
    if (ACT == 3) { return __builtin_amdgcn_rcpf(1.0f + __builtin_amdgcn_exp2f(-1.4426950408889634f * v)); }
    return v;
}
template <int ACT> struct EpiBf16 {
    static constexpr bool PERM = true, AFTER_DRAIN = false;
    bf16_t* O; int ldc;
    __device__ __forceinline__ void operator()(const f32x4 (&acc)[2][2][4][2], const Unit& u, int wr, int wc, int fr, int fq) const {
        const int row0 = u.pm * BM + wr * 64 + fr; const int col0 = u.pn * BM + wc * 32 + 8 * fq;
#pragma unroll
        for (int ai = 0; ai < 2; ++ai)
#pragma unroll
            for (int m = 0; m < 4; ++m) { bf16_t* rowp = O + (size_t)(row0 + ai * HALF + m * 16) * ldc + col0;
#pragma unroll
                for (int bj = 0; bj < 2; ++bj) { f32x4 v0 = acc[ai][bj][m][0], v1 = acc[ai][bj][m][1];
#pragma unroll
                    for (int e = 0; e < 4; ++e) { v0[e] = act_apply(ACT, v0[e]); v1[e] = act_apply(ACT, v1[e]); }
                    u32x4 w; w.x = cvt_pk_bf16(v0[0], v0[1]); w.y = cvt_pk_bf16(v0[2], v0[3]); w.z = cvt_pk_bf16(v1[0], v1[1]); w.w = cvt_pk_bf16(v1[2], v1[3]);
                    *(u32x4*)(rowp + bj * HALF) = w; } }
    }
};
struct EpiF32 {
    static constexpr bool PERM = false, AFTER_DRAIN = false;
    float* O; int ldc;
    __device__ __forceinline__ void operator()(const f32x4 (&acc)[2][2][4][2], const Unit& u, int wr, int wc, int fr, int fq) const {
        const int row0 = u.pm * BM + wr * 64 + fr; const int col0 = u.pn * BM + wc * 32 + 4 * fq;
#pragma unroll
        for (int ai = 0; ai < 2; ++ai)
#pragma unroll
            for (int m = 0; m < 4; ++m) { float* rowp = O + (size_t)(row0 + ai * HALF + m * 16) * ldc + col0;
#pragma unroll
                for (int bj = 0; bj < 2; ++bj)
#pragma unroll
                    for (int n = 0; n < 2; ++n) *(f32x4*)(rowp + bj * HALF + n * 16) = acc[ai][bj][m][n]; }
    }
};
template <class Epi, class Sched, bool ALIGN_EPI = false, bool SP2 = false>
__device__ __forceinline__ void gemm_phase(PG8_LAS unsigned char* lds, const Gemm g, const Sched& S, const Epi& E) {
    const int tid = threadIdx.x, wid = __builtin_amdgcn_readfirstlane(tid >> 6), lane = tid & 63, wr = wid >> 2, wc = wid & 3, fr = lane & 15, fq = lane >> 4;
    const int K = g.K, nt = K / BK;
    unsigned voffA[2], voffB[2];
#pragma unroll
    for (int i = 0; i < 2; ++i) { int R, C; stage_rc(tid * 16 + i * 8192, R, C); const int Rb = Epi::PERM ? ((R & ~31) + perm32(R & 31)) : R;
        voffA[i] = (unsigned)(R * K + C) * 2u; voffB[i] = (unsigned)(Rb * K + C) * 2u; }
    const size_t kstep = (size_t)(BK * 2);
    const size_t hstep = (size_t)HALF * K * 2;
    const size_t tstep = 2 * hstep;
    const unsigned ldsw = (unsigned)wid * 1024u;
    const int aoff = lds_byte(wr * 64 + fr, fq * 8), boff = lds_byte(wc * 32 + fr, fq * 8);
#define PG8_SA(b, h) (((b) * 2 + (h)) * HTB)
#define PG8_SB(b, h) ((4 + (b) * 2 + (h)) * HTB)
#define PG8_STAGE(bufoff, gbase, voff) do { _Pragma("unroll") for (int _i = 0; _i < 2; ++_i) \
        __builtin_amdgcn_global_load_lds((const unsigned*)((const char*)(gbase) + (voff)[_i]), (PG8_LAS unsigned*)(lds + (bufoff) + ldsw + _i * 8192), 16, 0, 0); } while (0)
#define PG8_LDA(dst, b, h) do { _Pragma("unroll") for (int m = 0; m < 4; ++m) _Pragma("unroll") for (int k = 0; k < 2; ++k) dst[m][k] = *(const PG8_LAS bf16x8*)(lds + PG8_SA(b, h) + aoff + m * 2048 + k * 1024); } while (0)
#define PG8_LDB(dst, b, h) do { _Pragma("unroll") for (int n = 0; n < 2; ++n) _Pragma("unroll") for (int k = 0; k < 2; ++k) dst[n][k] = *(const PG8_LAS bf16x8*)(lds + PG8_SB(b, h) + boff + n * 2048 + k * 1024); } while (0)
#define PG8_MMA(ai, bj, At, Bt) do { __builtin_amdgcn_s_setprio(1); _Pragma("unroll") for (int m = 0; m < 4; ++m) _Pragma("unroll") for (int n = 0; n < 2; ++n) _Pragma("unroll") for (int k = 0; k < 2; ++k) \
        acc[ai][bj][m][n] = __builtin_amdgcn_mfma_f32_16x16x32_bf16(Bt[n][k], At[m][k], acc[ai][bj][m][n], 0, 0, 0); __builtin_amdgcn_s_setprio(0); } while (0)
#define PG8_WAIT_V(n) asm volatile("s_waitcnt vmcnt(" #n ")" ::: "memory")
#define PG8_WAIT_L(n) asm volatile("s_waitcnt lgkmcnt(" #n ")" ::: "memory")
#define PG8_BAR __builtin_amdgcn_s_barrier()
#define PG8_SCHED __builtin_amdgcn_sched_barrier(0)
    Unit cur, nxt; int ui = 0;
    if (!S.next(0, cur)) return;
    f32x4 acc[2][2][4][2];
#pragma unroll
    for (int a = 0; a < 2; ++a)
#pragma unroll
        for (int b = 0; b < 2; ++b)
#pragma unroll
            for (int m = 0; m < 4; ++m)
#pragma unroll
                for (int n = 0; n < 2; ++n) acc[a][b][m][n] = (f32x4){0.f, 0.f, 0.f, 0.f};
    bf16x8 At[4][2], B0[2][2], B1[2][2];
    const char* cA = (const char*)g.A + (size_t)cur.pm * tstep; const char* cB = (const char*)g.Bt + (size_t)cur.pn * tstep;
    S.a_ready(cur);
    if constexpr (SP2) {
        PG8_STAGE(PG8_SB(0, 0), cB, voffB); PG8_STAGE(PG8_SB(0, 1), cB + hstep, voffB); PG8_STAGE(PG8_SA(0, 0), cA, voffA); PG8_STAGE(PG8_SA(0, 1), cA + hstep, voffA);
        if (wr == 1) PG8_BAR;
        PG8_WAIT_V(2); PG8_BAR;
        PG8_STAGE(PG8_SB(1, 0), cB + kstep, voffB); PG8_STAGE(PG8_SA(1, 0), cA + kstep, voffA); PG8_STAGE(PG8_SB(1, 1), cB + hstep + kstep, voffB);
        PG8_WAIT_V(6); PG8_BAR;
    } else {
        PG8_STAGE(PG8_SB(0, 0), cB, voffB); PG8_STAGE(PG8_SA(0, 0), cA, voffA); PG8_STAGE(PG8_SB(0, 1), cB + hstep, voffB); PG8_STAGE(PG8_SA(0, 1), cA + hstep, voffA);
        if (wr == 1) PG8_BAR;
        PG8_WAIT_V(4); PG8_BAR;
        PG8_STAGE(PG8_SB(1, 0), cB + kstep, voffB); PG8_STAGE(PG8_SA(1, 0), cA + kstep, voffA); PG8_STAGE(PG8_SB(1, 1), cB + hstep + kstep, voffB);
        PG8_WAIT_V(6); PG8_BAR;
    }
    for (;;) {
        const bool has_next = S.next(ui + 1, nxt);
        const char* nA = has_next ? (const char*)g.A + (size_t)nxt.pm * tstep : cA; const char* nB = has_next ? (const char*)g.Bt + (size_t)nxt.pn * tstep : cB;
        for (int t = 0; t < nt; t += 2) {
            const bool last = (t == nt - 2);
            const char* a1 = cA + (size_t)(t + 1) * kstep;
            const char* a2 = last ? nA : cA + (size_t)(t + 2) * kstep; const char* b2 = last ? nB : cB + (size_t)(t + 2) * kstep;
            const char* a3 = a2 + kstep; const char* b3 = b2 + kstep;
            if (last && has_next) S.a_ready(nxt);
            if constexpr (SP2) {
            PG8_LDB(B0, 0, 0); PG8_LDB(B1, 0, 1); PG8_SCHED; PG8_LDA(At, 0, 0); PG8_STAGE(PG8_SA(1, 1), a1 + hstep, voffA);
            PG8_WAIT_V(8); PG8_WAIT_L(0); PG8_BAR; PG8_MMA(0, 0, At, B0); PG8_MMA(0, 1, At, B1); PG8_BAR; PG8_SCHED;
            PG8_LDA(At, 0, 1); PG8_STAGE(PG8_SB(0, 0), b2, voffB); PG8_STAGE(PG8_SB(0, 1), b2 + hstep, voffB); PG8_STAGE(PG8_SA(0, 0), a2, voffA);
            PG8_WAIT_V(8); PG8_WAIT_L(0); PG8_BAR; PG8_MMA(1, 0, At, B0); PG8_MMA(1, 1, At, B1); PG8_BAR; PG8_SCHED;
            PG8_LDB(B0, 1, 0); PG8_LDB(B1, 1, 1); PG8_SCHED; PG8_LDA(At, 1, 0); PG8_STAGE(PG8_SA(0, 1), a2 + hstep, voffA);
            PG8_WAIT_V(8); PG8_WAIT_L(0); PG8_BAR; PG8_MMA(0, 0, At, B0); PG8_MMA(0, 1, At, B1); PG8_BAR; PG8_SCHED;
            PG8_LDA(At, 1, 1); PG8_STAGE(PG8_SB(1, 0), b3, voffB); PG8_STAGE(PG8_SB(1, 1), b3 + hstep, voffB); PG8_STAGE(PG8_SA(1, 0), a3, voffA);
            PG8_WAIT_V(8); PG8_WAIT_L(0); PG8_BAR; PG8_MMA(1, 0, At, B0); PG8_MMA(1, 1, At, B1); PG8_BAR; PG8_SCHED;
            } else {
            PG8_LDB(B0, 0, 0); PG8_SCHED; PG8_LDA(At, 0, 0); PG8_STAGE(PG8_SA(1, 1), a1 + hstep, voffA);
            PG8_WAIT_L(8); PG8_BAR; PG8_WAIT_L(0); PG8_MMA(0, 0, At, B0); PG8_BAR; PG8_SCHED;
            PG8_LDB(B1, 0, 1); PG8_STAGE(PG8_SB(0, 0), b2, voffB);
            PG8_BAR; PG8_WAIT_L(0); PG8_MMA(0, 1, At, B1); PG8_BAR;
            PG8_LDA(At, 0, 1); PG8_STAGE(PG8_SA(0, 0), a2, voffA);
            PG8_BAR; PG8_WAIT_L(0); PG8_MMA(1, 0, At, B0); PG8_BAR; PG8_SCHED;
            PG8_STAGE(PG8_SB(0, 1), b2 + hstep, voffB);
            PG8_WAIT_V(6); PG8_BAR; PG8_MMA(1, 1, At, B1); PG8_BAR;
            PG8_LDB(B0, 1, 0); PG8_SCHED; PG8_LDA(At, 1, 0); PG8_STAGE(PG8_SA(0, 1), a2 + hstep, voffA);
            PG8_WAIT_L(8); PG8_BAR; PG8_WAIT_L(0); PG8_MMA(0, 0, At, B0); PG8_BAR; PG8_SCHED;
            PG8_LDB(B1, 1, 1); PG8_STAGE(PG8_SB(1, 0), b3, voffB);
            PG8_BAR; PG8_WAIT_L(0); PG8_MMA(0, 1, At, B1); PG8_BAR;
            PG8_LDA(At, 1, 1); PG8_STAGE(PG8_SA(1, 0), a3, voffA);
            PG8_BAR; PG8_WAIT_L(0); PG8_MMA(1, 0, At, B0); PG8_BAR; PG8_SCHED;
            PG8_STAGE(PG8_SB(1, 1), b3 + hstep, voffB);
            PG8_WAIT_V(6); PG8_BAR; PG8_MMA(1, 1, At, B1); PG8_BAR;
            }
        }
        if constexpr (ALIGN_EPI) { if (wr == 0) PG8_BAR; }
        if constexpr (!Epi::AFTER_DRAIN) { E(acc, cur, wr, wc, fr, fq); S.done(cur); }
        if (!has_next) break;
#pragma unroll
        for (int a = 0; a < 2; ++a)
#pragma unroll
            for (int b = 0; b < 2; ++b)
#pragma unroll
                for (int m = 0; m < 4; ++m)
#pragma unroll
                    for (int n = 0; n < 2; ++n) acc[a][b][m][n] = (f32x4){0.f, 0.f, 0.f, 0.f};
        cur = nxt; cA = nA; cB = nB; ++ui;
        if constexpr (ALIGN_EPI) { if (wr == 1) PG8_BAR; }
    }
    PG8_WAIT_V(0);
    if constexpr (!ALIGN_EPI) { if (wr == 0) PG8_BAR; }
    PG8_BAR;
    if constexpr (Epi::AFTER_DRAIN) { E.fused(acc, cur, wr, wc, fr, fq, lds, wid, lane); S.done(cur); }
#undef PG8_SA
#undef PG8_SB
#undef PG8_STAGE
#undef PG8_LDA
#undef PG8_LDB
#undef PG8_MMA
#undef PG8_WAIT_V
#undef PG8_WAIT_L
#undef PG8_BAR
#undef PG8_SCHED
}
}
#define GAS __attribute__((address_space(1)))
#define LAS __attribute__((address_space(3)))
typedef unsigned short bf16;
typedef float f32x2v __attribute__((ext_vector_type(2)));
typedef unsigned v4u __attribute__((ext_vector_type(4)));
typedef float f32x4 __attribute__((ext_vector_type(4)));
typedef short bf16x8 __attribute__((ext_vector_type(8)));
typedef GAS unsigned gu32;
typedef GAS unsigned long long gu64;
#define RLX_AGENT __ATOMIC_RELAXED, __HIP_MEMORY_SCOPE_AGENT
#define LDS_WAIT() asm volatile("s_waitcnt lgkmcnt(0)" ::: "memory")
#define VM_WAIT() asm volatile("s_waitcnt vmcnt(0)" ::: "memory")
__device__ __forceinline__ unsigned long long rt() { return __builtin_amdgcn_s_memrealtime(); }
__device__ __forceinline__ unsigned f2bf(float f) { unsigned u = __builtin_bit_cast(unsigned, f); return (u + 0x7fffu + ((u >> 16) & 1u)) >> 16; }
__device__ __forceinline__ unsigned pk2(float lo, float hi) { return f2bf(lo) | (f2bf(hi) << 16); }

#define XB_TMO      128
#define XB_XCNT(j)  (256  + 64 * (j))
#define XB_XSUB(j)  (1280 + 64 * (j))
#define XB_XGEN(j)  (2304 + 64 * (j))
#define XB_TOP      3328
#define XB_TOPGEN   3392
#define XCD_BAR_WORDS 3456
#define XB_SPIN_CAP (1u << 18)

__device__ __forceinline__ unsigned xb_ld(unsigned* p)              { return __hip_atomic_load(p, __ATOMIC_RELAXED, __HIP_MEMORY_SCOPE_AGENT); }
__device__ __forceinline__ unsigned xb_add(unsigned* p, unsigned v) { return __hip_atomic_fetch_add(p, v, __ATOMIC_RELAXED, __HIP_MEMORY_SCOPE_AGENT); }
__device__ __forceinline__ unsigned xb_xcc_id() { return (unsigned)__builtin_amdgcn_s_getreg((3 << 11) | 20) & 0xFu; }
#define XB_SPIN(cond, bar) do { unsigned _sp = 0; while (cond) { __builtin_amdgcn_s_sleep(1); \
    if ((++_sp & 255u) == 0u) { if (xb_ld(&(bar)[XB_TMO])) break; if (_sp > XB_SPIN_CAP) { atomicAdd(&(bar)[XB_TMO], 1u); break; } } } } while (0)

struct XcdBarrier {
    unsigned* bar; unsigned x;
    volatile LAS unsigned* st;
};

__device__ __forceinline__ XcdBarrier xcd_barrier_post(unsigned* bar, volatile LAS unsigned* st) {
    XcdBarrier b; b.bar = bar; b.x = xb_xcc_id(); b.st = st;
    if (threadIdx.x == 0) (void)xb_add(&bar[XB_XCNT(b.x)], 1u);
    return b;
}
__device__ __forceinline__ void xcd_barrier_complete(unsigned* bar, unsigned x, unsigned& nloc, unsigned& nx) {
    const unsigned G = gridDim.x * gridDim.y * gridDim.z;
    unsigned sum, cnt, mine, sp = 0u;
    for (;;) {
        sum = 0u; cnt = 0u; mine = 0u;
#pragma unroll
        for (unsigned j = 0; j < 16; ++j) { const unsigned c = xb_ld(&bar[XB_XCNT(j)]); sum += c; cnt += (c > 0u) ? 1u : 0u; mine = (j == x) ? c : mine; }
        if (sum == G) break;
        __builtin_amdgcn_s_sleep(1);
        if ((++sp & 255u) == 0u) { if (xb_ld(&bar[XB_TMO])) break; if (sp > XB_SPIN_CAP) { atomicAdd(&bar[XB_TMO], 1u); break; } }
    }
    nloc = mine > 0u ? mine : 1u; nx = cnt > 0u ? cnt : 1u;
}

__device__ __forceinline__ void xcd_barrier(const XcdBarrier& b) {
    asm volatile("s_waitcnt vmcnt(0)" ::: "memory");
    __syncthreads();
    if (threadIdx.x == 0) {
        unsigned* bar = b.bar;
        __builtin_amdgcn_s_waitcnt(0);
        unsigned nloc = b.st[0], nx = b.st[1];
        if (nloc == 0u) { xcd_barrier_complete(bar, b.x, nloc, nx); b.st[0] = nloc; b.st[1] = nx; }
        const unsigned old = xb_add(&bar[XB_XSUB(b.x)], 1u);
        const unsigned gen = old / nloc;
        if (old + 1u == (gen + 1u) * nloc) {
            __builtin_amdgcn_fence(__ATOMIC_RELEASE, "agent");
            asm volatile("s_waitcnt vmcnt(0)" ::: "memory");
            const unsigned og = xb_add(&bar[XB_TOP], 1u);
            const unsigned tg = og / nx;
            if (og + 1u == (tg + 1u) * nx) xb_add(&bar[XB_TOPGEN], 1u);
            else XB_SPIN(xb_ld(&bar[XB_TOPGEN]) == tg, bar);
            __builtin_amdgcn_fence(__ATOMIC_ACQUIRE, "agent");
            xb_add(&bar[XB_XGEN(b.x)], 1u);
            asm volatile("s_waitcnt vmcnt(0)" ::: "memory");
        } else {
            XB_SPIN(xb_ld(&bar[XB_XGEN(b.x)]) == gen, bar);
            __builtin_amdgcn_fence(__ATOMIC_ACQUIRE, "agent");
            asm volatile("s_waitcnt vmcnt(0)" ::: "memory");
        }
    }
    __syncthreads();
}

constexpr int NWAVES = 8;
constexpr int BATCH = 8, SEQ = 4096, DM = 1024, M = BATCH * SEQ;
constexpr int NPROJ = 2816, NPROJ_SRC = 2824;
constexpr int FF = 4096, PLE = 256, NH = 8, HD = 64, SSD_N = 128, CONVC = 768, CHUNK = 128, NCHUNK = SEQ / CHUNK;
constexpr float EPS = 1e-6f;
constexpr float QSCALE = 0.125f * 1.4426950408889634f;

constexpr size_t MiB = 1u << 20;
constexpr size_t WS_CTL = 0, CTL_ZERO_BYTES = 1 * MiB;
constexpr size_t WS_DT = 1 * MiB;
constexpr size_t WS_TAB = 8 * MiB;
constexpr size_t WS_WIN = 16 * MiB, WS_WOUT = 22 * MiB, WS_WUP = 24 * MiB, WS_WDN = 32 * MiB, WS_WG = 40 * MiB, WS_WP = 42 * MiB;
constexpr size_t WS_XN = 48 * MiB;
constexpr size_t WS_PB = 112 * MiB;
constexpr size_t WS_H = 128 * MiB;
constexpr size_t WS_QKV = 128 * MiB;
constexpr size_t WS_Z = 224 * MiB;
constexpr size_t WS_XBC = 256 * MiB;
constexpr size_t WS_MIX = 256 * MiB;
constexpr size_t WS_PROJ = 320 * MiB;
constexpr size_t WS_XC = 384 * MiB;
constexpr size_t WS_Y = 128 * MiB;
constexpr size_t WS_T = 384 * MiB;
constexpr size_t WS_SIG = 128 * MiB;
constexpr size_t WS_END = 512 * MiB;
constexpr int CW_TMO = 0, CW_CODE = 1, CW_BAR = 4096;

constexpr int RING_OFF = 0, RING_BYTES = 131072;
constexpr int LDSCTL_OFF = RING_BYTES, MISC_OFF = LDSCTL_OFF + 320;
constexpr int LDS_BYTES = 147456;

struct Args { const void* in[20]; float* out; unsigned char* ws; int ph_lo, ph_hi; float inv_freq[32]; };
struct Frame {
    LAS unsigned char* lds;
    volatile LAS unsigned* MISC;
    gu32* ctl;
    int tid, lane, wave, vcu, G;
};
typedef unsigned v2u __attribute__((ext_vector_type(2)));
__device__ __forceinline__ float bf2f(unsigned short b) { return __builtin_bit_cast(float, (unsigned)b << 16); }
__device__ __forceinline__ float bflo(unsigned w) { return __builtin_bit_cast(float, w << 16); }
__device__ __forceinline__ float bfhi(unsigned w) { return __builtin_bit_cast(float, w & 0xffff0000u); }
__device__ __forceinline__ float wave_sum(float v) {
#pragma unroll
    for (int o = 1; o < 64; o <<= 1) v += __shfl_xor(v, o);
    return v;
}
__device__ __forceinline__ float silu_f(float v) { return v / (1.0f + __expf(-v)); }

__device__ __forceinline__ void p0_transpose_item(const float* W, int K, int ldw, int ncols, bf16* WT, LAS float* scr, int item, int lane) {
    const int nblk = ncols / 32, kb = item / nblk, nb = item % nblk, k0 = 64 * kb, n0 = 32 * nb;
#pragma unroll 8
    for (int i = 0; i < 32; ++i) { const int kk = 2 * i + (lane >> 5); scr[kk * 33 + (lane & 31)] = W[(size_t)(k0 + kk) * ldw + n0 + (lane & 31)]; }
    LDS_WAIT(); asm volatile("" ::: "memory");
    const int c = lane & 7;
#pragma unroll
    for (int j = 0; j < 4; ++j) { const int n = (lane >> 3) + 8 * j; const LAS float* s = scr + (8 * c) * 33 + n;
        v4u o; o.x = pk2(s[0 * 33], s[1 * 33]); o.y = pk2(s[2 * 33], s[3 * 33]); o.z = pk2(s[4 * 33], s[5 * 33]); o.w = pk2(s[6 * 33], s[7 * 33]);
        *(GAS v4u*)(WT + (size_t)(n0 + n) * K + k0 + 8 * c) = o; }
    LDS_WAIT(); asm volatile("" ::: "memory");
}
__device__ __forceinline__ void p0_prologue(Frame& F, const Args& A) {
    unsigned char* ws = A.ws;
    LAS float* scr = (LAS float*)(F.lds + RING_OFF + F.wave * 16384);
    const int gw = F.vcu * NWAVES + F.wave, NGW = F.G * NWAVES;
    const float* w_in = (const float*)A.in[5]; const float* w_out = (const float*)A.in[12]; const float* w_up = (const float*)A.in[15];
    const float* w_dn = (const float*)A.in[16]; const float* w_g = (const float*)A.in[17]; const float* w_p = (const float*)A.in[18];
    constexpr int I_IN = (DM / 64) * (NPROJ / 32), I_OUT = (DM / 64) * (DM / 32), I_UP = (DM / 64) * (FF / 32), I_DN = (FF / 64) * (DM / 32), I_G = I_OUT, I_P = (PLE / 64) * (DM / 32);
    constexpr int NITEMS = I_IN + I_OUT + I_UP + I_DN + I_G + I_P;
    for (int it = gw; it < NITEMS; it += NGW) {
        int r = it;
        if (r < I_IN) { p0_transpose_item(w_in, DM, NPROJ_SRC, NPROJ, (bf16*)(ws + WS_WIN), scr, r, F.lane); continue; } r -= I_IN;
        if (r < I_OUT) { p0_transpose_item(w_out, DM, DM, DM, (bf16*)(ws + WS_WOUT), scr, r, F.lane); continue; } r -= I_OUT;
        if (r < I_UP) { p0_transpose_item(w_up, DM, FF, FF, (bf16*)(ws + WS_WUP), scr, r, F.lane); continue; } r -= I_UP;
        if (r < I_DN) { p0_transpose_item(w_dn, FF, DM, DM, (bf16*)(ws + WS_WDN), scr, r, F.lane); continue; } r -= I_DN;
        if (r < I_G) { p0_transpose_item(w_g, DM, DM, DM, (bf16*)(ws + WS_WG), scr, r, F.lane); continue; } r -= I_G;
        p0_transpose_item(w_p, PLE, DM, DM, (bf16*)(ws + WS_WP), scr, r, F.lane);
    }
    const float* x = (const float*)A.in[0]; const float* pin = (const float*)A.in[1]; const int* pos = (const int*)A.in[2];
    const float* g_pre = (const float*)A.in[3]; const float* dt_bias = (const float*)A.in[8];
    bf16* XN = (bf16*)(ws + WS_XN); bf16* PB = (bf16*)(ws + WS_PB); float* DT = (float*)(ws + WS_DT); float* TAB = (float*)(ws + WS_TAB);
    const int lane = F.lane;
    const float myfreq = A.inv_freq[lane & 31];
    for (int m = gw; m < M; m += NGW) {
        const GAS f32x4* xr = (const GAS f32x4*)(x + (size_t)m * DM) + lane;
        const GAS f32x4* gr = (const GAS f32x4*)g_pre + lane;
        f32x4 v[4]; float ss = 0.f;
#pragma unroll
        for (int j = 0; j < 4; ++j) { v[j] = xr[64 * j]; ss += (v[j].x * v[j].x + v[j].y * v[j].y) + (v[j].z * v[j].z + v[j].w * v[j].w); }
        const float rstd = 1.0f / sqrtf(wave_sum(ss) * (1.f / DM) + EPS);
        GAS unsigned long long* o8 = (GAS unsigned long long*)(XN + (size_t)m * DM) + lane;
        float dacc[8];
#pragma unroll
        for (int q = 0; q < 8; ++q) dacc[q] = 0.f;
#pragma unroll
        for (int j = 0; j < 4; ++j) {
            const f32x4 g = gr[64 * j]; v[j] = v[j] * rstd * g;
            o8[64 * j] = (unsigned long long)pk2(v[j].x, v[j].y) | ((unsigned long long)pk2(v[j].z, v[j].w) << 32);
#pragma unroll
            for (int e = 0; e < 4; ++e) {
                const int k = 256 * j + 4 * lane + e;
                const GAS f32x4* wp = (const GAS f32x4*)(w_in + (size_t)k * NPROJ_SRC + NPROJ);
                const f32x4 w0 = wp[0], w1 = wp[1]; const float uv = v[j][e];
                dacc[0] += uv * w0.x; dacc[1] += uv * w0.y; dacc[2] += uv * w0.z; dacc[3] += uv * w0.w;
                dacc[4] += uv * w1.x; dacc[5] += uv * w1.y; dacc[6] += uv * w1.z; dacc[7] += uv * w1.w;
            }
        }
#pragma unroll
        for (int q = 0; q < 8; ++q) dacc[q] = wave_sum(dacc[q]);
        if (lane < 8) {
            float d = dacc[0];
#pragma unroll
            for (int q = 1; q < 8; ++q) d = (lane == q) ? dacc[q] : d;
            d += dt_bias[lane];
            const float sp = d > 20.f ? d : log1pf(expf(d));
            DT[(size_t)m * 8 + lane] = sp;
        }
        if (lane < 32) {
            const float ang = (float)pos[m] * myfreq; float sn, cs; sincosf(ang, &sn, &cs);
            *(GAS f32x2v*)(TAB + ((size_t)m * 32 + lane) * 2) = (f32x2v){cs, sn};
        }
        { const f32x4 pv = *((const GAS f32x4*)(pin + (size_t)m * PLE) + lane);
          *((GAS unsigned long long*)(PB + (size_t)m * PLE) + lane) = (unsigned long long)pk2(pv.x, pv.y) | ((unsigned long long)pk2(pv.z, pv.w) << 32); }
    }
}

__device__ __forceinline__ void p_split(Frame& F, const Args& A) {
    unsigned char* ws = A.ws;
    const bf16* PROJ = (const bf16*)(ws + WS_PROJ); bf16* QKV = (bf16*)(ws + WS_QKV); bf16* Z = (bf16*)(ws + WS_Z); bf16* XBC = (bf16*)(ws + WS_XBC);
    const float* TAB = (const float*)(ws + WS_TAB);
    const long gt = (long)F.vcu * (NWAVES * 64) + F.tid, NT = (long)F.G * NWAVES * 64;
    for (long it = gt; it < (long)M * 288; it += NT) {
        const int row = (int)(it / 288), c = (int)(it % 288);
        const bf16* src = PROJ + (size_t)row * NPROJ;
        if (c < 64) {
            const int hd = c >> 2, i0 = 8 * (c & 3); const float sc = hd < 8 ? QSCALE : 1.0f;
            const v4u a = *(const GAS v4u*)(src + hd * 64 + i0), b = *(const GAS v4u*)(src + hd * 64 + 32 + i0);
            const GAS f32x4* tb = (const GAS f32x4*)(TAB + ((size_t)row * 32 + i0) * 2);
            float t1[8], t2[8], o1[8], o2[8];
            t1[0] = bflo(a.x); t1[1] = bfhi(a.x); t1[2] = bflo(a.y); t1[3] = bfhi(a.y); t1[4] = bflo(a.z); t1[5] = bfhi(a.z); t1[6] = bflo(a.w); t1[7] = bfhi(a.w);
            t2[0] = bflo(b.x); t2[1] = bfhi(b.x); t2[2] = bflo(b.y); t2[3] = bfhi(b.y); t2[4] = bflo(b.z); t2[5] = bfhi(b.z); t2[6] = bflo(b.w); t2[7] = bfhi(b.w);
#pragma unroll
            for (int e2 = 0; e2 < 4; ++e2) { const f32x4 cs = tb[e2];
                o1[2 * e2] = (t1[2 * e2] * cs.x - t2[2 * e2] * cs.y) * sc; o2[2 * e2] = (t2[2 * e2] * cs.x + t1[2 * e2] * cs.y) * sc;
                o1[2 * e2 + 1] = (t1[2 * e2 + 1] * cs.z - t2[2 * e2 + 1] * cs.w) * sc; o2[2 * e2 + 1] = (t2[2 * e2 + 1] * cs.z + t1[2 * e2 + 1] * cs.w) * sc; }
            v4u w1, w2; w1.x = pk2(o1[0], o1[1]); w1.y = pk2(o1[2], o1[3]); w1.z = pk2(o1[4], o1[5]); w1.w = pk2(o1[6], o1[7]);
            w2.x = pk2(o2[0], o2[1]); w2.y = pk2(o2[2], o2[3]); w2.z = pk2(o2[4], o2[5]); w2.w = pk2(o2[6], o2[7]);
            bf16* dst = QKV + (size_t)row * 1536 + hd * 64 + i0;
            *(GAS v4u*)dst = w1; *(GAS v4u*)(dst + 32) = w2;
        } else if (c < 128) {
            const int col = 1024 + 8 * (c - 64);
            *(GAS v4u*)(QKV + (size_t)row * 1536 + col) = *(const GAS v4u*)(src + col);
        } else if (c < 192) {
            const int cc = 8 * (c - 128); const v4u a = *(const GAS v4u*)(src + 1536 + cc); v4u w;
            w.x = pk2(silu_f(bflo(a.x)), silu_f(bfhi(a.x))); w.y = pk2(silu_f(bflo(a.y)), silu_f(bfhi(a.y)));
            w.z = pk2(silu_f(bflo(a.z)), silu_f(bfhi(a.z))); w.w = pk2(silu_f(bflo(a.w)), silu_f(bfhi(a.w)));
            *(GAS v4u*)(Z + (size_t)row * 512 + cc) = w;
        } else {
            const int cc = 8 * (c - 192);
            *(GAS v4u*)(XBC + (size_t)row * CONVC + cc) = *(const GAS v4u*)(src + 2048 + cc);
        }
    }
}

__device__ __forceinline__ void p_conv_naive(Frame& F, const Args& A) {
    unsigned char* ws = A.ws;
    const bf16* XBC = (const bf16*)(ws + WS_XBC); float* XC = (float*)(ws + WS_XC);
    const float* cw = (const float*)A.in[6]; const float* cb = (const float*)A.in[7];
    const long gt = (long)F.vcu * (NWAVES * 64) + F.tid, NT = (long)F.G * NWAVES * 64;
    for (long it = gt; it < (long)M * 96; it += NT) {
        const int row = (int)(it / 96), col = 8 * (int)(it % 96), t = row & (SEQ - 1);
        float acc[8];
#pragma unroll
        for (int e = 0; e < 8; ++e) acc[e] = cb[col + e];
#pragma unroll
        for (int w = 0; w < 4; ++w) {
            if (t - 3 + w >= 0) {
                const v4u a = *(const GAS v4u*)(XBC + (size_t)(row - 3 + w) * CONVC + col);
                const float* wp = cw + w * CONVC + col;
                acc[0] += bflo(a.x) * wp[0]; acc[1] += bfhi(a.x) * wp[1]; acc[2] += bflo(a.y) * wp[2]; acc[3] += bfhi(a.y) * wp[3];
                acc[4] += bflo(a.z) * wp[4]; acc[5] += bfhi(a.z) * wp[5]; acc[6] += bflo(a.w) * wp[6]; acc[7] += bfhi(a.w) * wp[7];
            }
        }
        f32x4 o0, o1; o0.x = silu_f(acc[0]); o0.y = silu_f(acc[1]); o0.z = silu_f(acc[2]); o0.w = silu_f(acc[3]);
        o1.x = silu_f(acc[4]); o1.y = silu_f(acc[5]); o1.z = silu_f(acc[6]); o1.w = silu_f(acc[7]);
        GAS f32x4* dst = (GAS f32x4*)(XC + (size_t)row * CONVC + col); dst[0] = o0; dst[1] = o1;
    }
}

__device__ __forceinline__ void p_attn_naive(Frame& F, const Args& A) {
    unsigned char* ws = A.ws;
    const bf16* QKV = (const bf16*)(ws + WS_QKV); bf16* MIX = (bf16*)(ws + WS_MIX);
    const long gt = (long)F.vcu * (NWAVES * 64) + F.tid, NT = (long)F.G * NWAVES * 64;
    for (long it = gt; it < (long)M * NH; it += NT) {
        const int h = (int)(it & 7), row = (int)(it >> 3), b = row >> 12, t = row & (SEQ - 1);
        float q[64], o[64];
        { const GAS v4u* qp = (const GAS v4u*)(QKV + (size_t)row * 1536 + h * 64);
#pragma unroll
          for (int c = 0; c < 8; ++c) { const v4u a = qp[c]; q[8 * c] = bflo(a.x); q[8 * c + 1] = bfhi(a.x); q[8 * c + 2] = bflo(a.y); q[8 * c + 3] = bfhi(a.y);
              q[8 * c + 4] = bflo(a.z); q[8 * c + 5] = bfhi(a.z); q[8 * c + 6] = bflo(a.w); q[8 * c + 7] = bfhi(a.w); } }
#pragma unroll
        for (int i = 0; i < 64; ++i) o[i] = 0.f;
        float mx = -INFINITY, l = 0.f;
        for (int br = 0; br < 3; ++br) {
            const int d = br == 0 ? 1 : (br == 1 ? 4 : 16);
            for (int j = 0; j <= 128; ++j) {
                const int tk = t - d * j; if (tk < 0) break;
                const size_t krow = (size_t)(b * SEQ + tk);
                const GAS v4u* kp = (const GAS v4u*)(QKV + krow * 1536 + 512 + h * 64);
                const GAS v4u* vp = (const GAS v4u*)(QKV + krow * 1536 + 1024 + h * 64);
                float s = 0.f;
#pragma unroll
                for (int c = 0; c < 8; ++c) { const v4u a = kp[c];
                    s += q[8 * c] * bflo(a.x) + q[8 * c + 1] * bfhi(a.x) + q[8 * c + 2] * bflo(a.y) + q[8 * c + 3] * bfhi(a.y)
                       + q[8 * c + 4] * bflo(a.z) + q[8 * c + 5] * bfhi(a.z) + q[8 * c + 6] * bflo(a.w) + q[8 * c + 7] * bfhi(a.w); }
                if (s > mx) { const float f = exp2f(mx - s); l *= f;
#pragma unroll
                    for (int i = 0; i < 64; ++i) o[i] *= f;
                    mx = s; }
                const float p = exp2f(s - mx); l += p;
#pragma unroll
                for (int c = 0; c < 8; ++c) { const v4u a = vp[c];
                    o[8 * c] += p * bflo(a.x); o[8 * c + 1] += p * bfhi(a.x); o[8 * c + 2] += p * bflo(a.y); o[8 * c + 3] += p * bfhi(a.y);
                    o[8 * c + 4] += p * bflo(a.z); o[8 * c + 5] += p * bfhi(a.z); o[8 * c + 6] += p * bflo(a.w); o[8 * c + 7] += p * bfhi(a.w); }
            }
        }
        const float rl = 1.0f / l;
        GAS v4u* dst = (GAS v4u*)(MIX + (size_t)row * 1024 + h * 64);
#pragma unroll
        for (int c = 0; c < 8; ++c) { v4u w; w.x = pk2(o[8 * c] * rl, o[8 * c + 1] * rl); w.y = pk2(o[8 * c + 2] * rl, o[8 * c + 3] * rl);
            w.z = pk2(o[8 * c + 4] * rl, o[8 * c + 5] * rl); w.w = pk2(o[8 * c + 6] * rl, o[8 * c + 7] * rl); dst[c] = w; }
    }
}

__device__ __forceinline__ void p_ssd_naive(Frame& F, const Args& A) {
    unsigned char* ws = A.ws;
    const float* XC = (const float*)(ws + WS_XC); const float* DT = (const float*)(ws + WS_DT); float* Y = (float*)(ws + WS_Y);
    const float* a_log = (const float*)A.in[9]; const float* d_skip = (const float*)A.in[10];
    const int gw = F.vcu * NWAVES + F.wave, NGW = F.G * NWAVES, lane = F.lane;
    for (int it = gw; it < BATCH * NH * HD; it += NGW) {
        const int b = it >> 9, h = (it >> 6) & 7, p = it & 63;
        const float Ah = -expf(a_log[h]), Dh = d_skip[h];
        float h0 = 0.f, h1 = 0.f;
        for (int t0 = 0; t0 < SEQ; t0 += 8) {
            float dtv[8], xv[8]; f32x2v Bv[8], Cv[8];
#pragma unroll
            for (int u = 0; u < 8; ++u) { const size_t row = (size_t)b * SEQ + t0 + u;
                dtv[u] = DT[row * 8 + h]; xv[u] = XC[row * CONVC + h * 64 + p];
                Bv[u] = *(const GAS f32x2v*)(XC + row * CONVC + 512 + 2 * lane); Cv[u] = *(const GAS f32x2v*)(XC + row * CONVC + 640 + 2 * lane); }
#pragma unroll
            for (int u = 0; u < 8; ++u) { const float dec = expf(dtv[u] * Ah), xdt = xv[u] * dtv[u];
                h0 = dec * h0 + Bv[u].x * xdt; h1 = dec * h1 + Bv[u].y * xdt;
                const float y = wave_sum(Cv[u].x * h0 + Cv[u].y * h1);
                if (lane == 0) Y[((size_t)b * SEQ + t0 + u) * 512 + h * 64 + p] = y + Dh * xv[u]; }
        }
    }
}

__device__ __forceinline__ void p_gate_naive(Frame& F, const Args& A) {
    unsigned char* ws = A.ws;
    const float* Y = (const float*)(ws + WS_Y); const bf16* Z = (const bf16*)(ws + WS_Z); bf16* MIX = (bf16*)(ws + WS_MIX);
    const float* g = (const float*)A.in[11];
    const int gw = F.vcu * NWAVES + F.wave, NGW = F.G * NWAVES, lane = F.lane;
    for (int m = gw; m < M; m += NGW) {
        const GAS f32x4* yp = (const GAS f32x4*)(Y + (size_t)m * 512 + 8 * lane); const f32x4 y0 = yp[0], y1 = yp[1];
        const v4u z = *(const GAS v4u*)(Z + (size_t)m * 512 + 8 * lane);
        float v[8]; v[0] = y0.x * bflo(z.x); v[1] = y0.y * bfhi(z.x); v[2] = y0.z * bflo(z.y); v[3] = y0.w * bfhi(z.y);
        v[4] = y1.x * bflo(z.z); v[5] = y1.y * bfhi(z.z); v[6] = y1.z * bflo(z.w); v[7] = y1.w * bfhi(z.w);
        float ss = 0.f;
#pragma unroll
        for (int e = 0; e < 8; ++e) ss += v[e] * v[e];
        const float rstd = 1.0f / sqrtf(wave_sum(ss) * (1.f / 512.f) + EPS);
        const GAS f32x4* gp = (const GAS f32x4*)(g + 8 * lane); const f32x4 g0 = gp[0], g1 = gp[1];
        v4u w; w.x = pk2(v[0] * rstd * g0.x, v[1] * rstd * g0.y); w.y = pk2(v[2] * rstd * g0.z, v[3] * rstd * g0.w);
        w.z = pk2(v[4] * rstd * g1.x, v[5] * rstd * g1.y); w.w = pk2(v[6] * rstd * g1.z, v[7] * rstd * g1.w);
        *(GAS v4u*)(MIX + (size_t)m * 1024 + 512 + 8 * lane) = w;
    }
}

template <int MODE> __device__ __forceinline__ void p_rows(Frame& F, const Args& A, const float* ga, const float* gb) {
    unsigned char* ws = A.ws;
    const float* T = (const float*)(ws + WS_T); const float* x = (const float*)A.in[0]; float* out = A.out;
    bf16* XN = (bf16*)(ws + WS_XN); const bf16* SIG = (const bf16*)(ws + WS_SIG);
    const int gw = F.vcu * NWAVES + F.wave, NGW = F.G * NWAVES, lane = F.lane;
    for (int m = gw; m < M; m += NGW) {
        const GAS f32x4* tr = (const GAS f32x4*)(T + (size_t)m * DM) + lane;
        const GAS f32x4* br = (const GAS f32x4*)((MODE == 0 ? x : (const float*)out) + (size_t)m * DM) + lane;
        GAS f32x4* orow = (GAS f32x4*)(out + (size_t)m * DM) + lane;
        f32x4 v[4], bs[4]; float ss = 0.f;
#pragma unroll
        for (int j = 0; j < 4; ++j) { v[j] = tr[64 * j]; bs[j] = br[64 * j];
            if (MODE == 2) { const v2u s = *((const GAS v2u*)(SIG + (size_t)m * DM) + lane + 64 * j); v[j].x *= bflo(s.x); v[j].y *= bfhi(s.x); v[j].z *= bflo(s.y); v[j].w *= bfhi(s.y); }
            ss += (v[j].x * v[j].x + v[j].y * v[j].y) + (v[j].z * v[j].z + v[j].w * v[j].w); }
        const float rstd = 1.0f / sqrtf(wave_sum(ss) * (1.f / DM) + EPS);
        float s2 = 0.f;
#pragma unroll
        for (int j = 0; j < 4; ++j) { const f32x4 g = *((const GAS f32x4*)ga + lane + 64 * j);
            v[j] = bs[j] + v[j] * rstd * g; orow[64 * j] = v[j];
            s2 += (v[j].x * v[j].x + v[j].y * v[j].y) + (v[j].z * v[j].z + v[j].w * v[j].w); }
        if (MODE == 0) {
            const float r2 = 1.0f / sqrtf(wave_sum(s2) * (1.f / DM) + EPS);
            GAS unsigned long long* o8 = (GAS unsigned long long*)(XN + (size_t)m * DM) + lane;
#pragma unroll
            for (int j = 0; j < 4; ++j) { const f32x4 g = *((const GAS f32x4*)gb + lane + 64 * j); const f32x4 u = v[j] * r2 * g;
                o8[64 * j] = (unsigned long long)pk2(u.x, u.y) | ((unsigned long long)pk2(u.z, u.w) << 32); }
        } else if (MODE == 1) {
            GAS unsigned long long* o8 = (GAS unsigned long long*)(XN + (size_t)m * DM) + lane;
#pragma unroll
            for (int j = 0; j < 4; ++j) o8[64 * j] = (unsigned long long)pk2(v[j].x, v[j].y) | ((unsigned long long)pk2(v[j].z, v[j].w) << 32);
        }
    }
}
template <int ACT, bool OUTBF> __device__ __forceinline__ void p_check_gemm(Frame& F, const bf16* Amat, const bf16* Bt, int K, int N, const void* C, int id) {
    const long gt = (long)F.vcu * (NWAVES * 64) + F.tid;
    unsigned hsh = (unsigned)gt * 2654435761u + 12345u * (unsigned)(id + 1);
    for (int s = 0; s < 16; ++s) {
        hsh = hsh * 1664525u + 1013904223u; const int row = (int)((hsh >> 8) % (unsigned)M);
        hsh = hsh * 1664525u + 1013904223u; const int col = (int)((hsh >> 8) % (unsigned)N);
        float acc = 0.f;
        for (int k = 0; k < K; ++k) acc += bf2f(Amat[(size_t)row * K + k]) * bf2f(Bt[(size_t)col * K + k]);
        acc = pg8::act_apply(ACT, acc);
        const float got = OUTBF ? bf2f(((const bf16*)C)[(size_t)row * N + col]) : ((const float*)C)[(size_t)row * N + col];
        const float err = fabsf(got - acc);
        if (!(err <= 0.02f * fabsf(acc) + 0.02f)) atomicAdd((unsigned*)(F.ctl + 64 + id), 1u);
    }
}

constexpr int N_PHASES = 15;
__global__ void __launch_bounds__(NWAVES * 64, 2) mk_fwd(Args args) {
    extern __shared__ __attribute__((aligned(16))) unsigned char lds[];
    Frame F;
    F.lds = (LAS unsigned char*)lds;
    F.MISC = (volatile LAS unsigned*)(F.lds + MISC_OFF);
    F.tid = threadIdx.x; F.lane = F.tid & 63; F.wave = __builtin_amdgcn_readfirstlane(F.tid >> 6);
    F.G = gridDim.x; { const int bx = blockIdx.x; F.vcu = (F.G % 8 == 0) ? (bx % 8) * (F.G / 8) + bx / 8 : bx; }
    unsigned char* ws = args.ws;
    F.ctl = (gu32*)(ws + WS_CTL);
    for (int u = F.tid; u < (LDS_BYTES - LDSCTL_OFF) / 4; u += NWAVES * 64) ((LAS unsigned*)(F.lds + LDSCTL_OFF))[u] = 0u;
    __syncthreads();
    const int lo = args.ph_lo, hi = args.ph_hi;
    const bool multi = (hi - lo) > 1;
    XcdBarrier bar; bar.bar = (unsigned*)(F.ctl + CW_BAR); bar.x = 0; bar.st = nullptr;
    if (multi) bar = xcd_barrier_post((unsigned*)(F.ctl + CW_BAR), F.MISC + 8);
#define IN(k) (lo <= (k) && (k) < hi)
#define SEAM(k) do { if (IN(k) && IN((k) + 1)) xcd_barrier(bar); } while (0)

    if (IN(0)) { p0_prologue(F, args); } SEAM(0);
    if (IN(1)) { pg8::Gemm g{(const bf16*)(ws + WS_XN), (const bf16*)(ws + WS_WIN), M, NPROJ, DM}; pg8::StaticOrder S; S.init(M, NPROJ, F.G, (int)blockIdx.x);
        pg8::EpiBf16<0> E{(bf16*)(ws + WS_PROJ), NPROJ};
        pg8::gemm_phase<pg8::EpiBf16<0>, pg8::StaticOrder, true, true>(F.lds + RING_OFF, g, S, E); } SEAM(1);
    if (IN(2)) { p_split(F, args); } SEAM(2);
    if (IN(3)) { p_conv_naive(F, args); } SEAM(3);
    if (IN(4)) { p_attn_naive(F, args); } SEAM(4);
    if (IN(5)) { p_ssd_naive(F, args); } SEAM(5);
    if (IN(6)) { p_gate_naive(F, args); } SEAM(6);
    if (IN(7)) { pg8::Gemm g{(const bf16*)(ws + WS_MIX), (const bf16*)(ws + WS_WOUT), M, DM, DM}; pg8::StaticOrder S; S.init(M, DM, F.G, (int)blockIdx.x);
        pg8::EpiF32 E{(float*)(ws + WS_T), DM};
        pg8::gemm_phase<pg8::EpiF32, pg8::StaticOrder, true, true>(F.lds + RING_OFF, g, S, E); } SEAM(7);
    if (IN(8)) { p_rows<0>(F, args, (const float*)args.in[4], (const float*)args.in[13]); } SEAM(8);
    if (IN(9)) { pg8::Gemm g{(const bf16*)(ws + WS_XN), (const bf16*)(ws + WS_WUP), M, FF, DM}; pg8::StaticOrder S; S.init(M, FF, F.G, (int)blockIdx.x);
        pg8::EpiBf16<2> E{(bf16*)(ws + WS_H), FF};
        pg8::gemm_phase<pg8::EpiBf16<2>, pg8::StaticOrder, true, true>(F.lds + RING_OFF, g, S, E); } SEAM(9);
    if (IN(10)) { pg8::Gemm g{(const bf16*)(ws + WS_H), (const bf16*)(ws + WS_WDN), M, DM, FF}; pg8::StaticOrder S; S.init(M, DM, F.G, (int)blockIdx.x);
        pg8::EpiF32 E{(float*)(ws + WS_T), DM};
        pg8::gemm_phase<pg8::EpiF32, pg8::StaticOrder, true, true>(F.lds + RING_OFF, g, S, E); } SEAM(10);
    if (IN(11)) { p_rows<1>(F, args, (const float*)args.in[14], nullptr); } SEAM(11);
    if (IN(12)) { pg8::Gemm g{(const bf16*)(ws + WS_XN), (const bf16*)(ws + WS_WG), M, DM, DM}; pg8::StaticOrder S; S.init(M, DM, F.G, (int)blockIdx.x);
        pg8::EpiBf16<3> E{(bf16*)(ws + WS_SIG), DM};
        pg8::gemm_phase<pg8::EpiBf16<3>, pg8::StaticOrder, true, true>(F.lds + RING_OFF, g, S, E); } SEAM(12);
    if (IN(13)) { pg8::Gemm g{(const bf16*)(ws + WS_PB), (const bf16*)(ws + WS_WP), M, DM, PLE}; pg8::StaticOrder S; S.init(M, DM, F.G, (int)blockIdx.x);
        pg8::EpiF32 E{(float*)(ws + WS_T), DM};
        pg8::gemm_phase<pg8::EpiF32, pg8::StaticOrder, true, true>(F.lds + RING_OFF, g, S, E); } SEAM(13);
    if (IN(14)) { p_rows<2>(F, args, (const float*)args.in[19], nullptr); }
#undef IN
#undef SEAM
}

extern "C" void kernel_launch(void* const* d_in, const int* in_sizes, int n_in, void* d_out, int out_size, void* d_ws, size_t ws_size, hipStream_t stream) {
    static int grid = 0;
    if (grid == 0) {
        if (n_in != 20 || in_sizes[0] != M * DM || out_size != M * DM || ws_size < WS_END) {
            fprintf(stderr, "kernel_launch: unexpected shapes: n_in %d in0 %d out %d ws %zu; nothing launched\n", n_in, n_in > 0 ? in_sizes[0] : -1, out_size, ws_size); grid = -1; return; }
        int dev = 0, cus = 0, per_cu = 0;
        if (hipGetDevice(&dev) != hipSuccess || hipDeviceGetAttribute(&cus, hipDeviceAttributeMultiprocessorCount, dev) != hipSuccess) { grid = -1; return; }
        if (hipFuncSetAttribute((const void*)mk_fwd, hipFuncAttributeMaxDynamicSharedMemorySize, LDS_BYTES) != hipSuccess) { fprintf(stderr, "kernel_launch: hipFuncSetAttribute failed\n"); grid = -1; return; }
        if (hipOccupancyMaxActiveBlocksPerMultiprocessor(&per_cu, (const void*)mk_fwd, NWAVES * 64, LDS_BYTES) != hipSuccess || per_cu < 1) {
            fprintf(stderr, "kernel_launch: occupancy query reports %d blocks per CU\n", per_cu); }
        (void)hipGetLastError();
        grid = cus;
    }
    if (grid < 0) return;
    (void)hipMemsetAsync((char*)d_ws + WS_CTL, 0, CTL_ZERO_BYTES, stream);
    Args a{};
    for (int i = 0; i < 20; ++i) a.in[i] = d_in[i];
    a.out = (float*)d_out; a.ws = (unsigned char*)d_ws;
    for (int i = 0; i < 32; ++i) a.inv_freq[i] = (float)pow(10000.0, -(double)i / 32.0);
#ifndef MK_ONE_LAUNCH
    for (int ph = 0; ph < N_PHASES; ++ph) { a.ph_lo = ph; a.ph_hi = ph + 1; hipLaunchKernelGGL(mk_fwd, dim3(grid), dim3(NWAVES * 64), LDS_BYTES, stream, a); }
#else
    a.ph_lo = 0; a.ph_hi = N_PHASES; hipLaunchKernelGGL(mk_fwd, dim3(grid), dim3(NWAVES * 64), LDS_BYTES, stream, a);
#endif
}
```

```cpp
#include <hip/hip_bf16.h>
#include <cmath>
#include <hip/hip_runtime.h>
#include <cstdio>
#include <cstdint>
namespace pg8 {
#define PG8_LAS __attribute__((address_space(3)))
typedef unsigned short bf16_t;
typedef short bf16x8 __attribute__((ext_vector_type(8)));
typedef float f32x4 __attribute__((ext_vector_type(4)));
typedef unsigned u32x4 __attribute__((ext_vector_type(4)));
constexpr int BM = 256, BK = 64, HALF = 128, HTB = HALF * BK * 2  , STAGE_BYTES = 8 * HTB, NXCD = 8, WGM = 8;

__host__ __device__ __forceinline__ int lds_byte(int r, int c) { const int st = (r >> 4) * 2 + (c >> 5), rr = r & 15, cc = c & 31, ob = rr * 64 + cc * 2; return st * 1024 + (ob ^ (((ob >> 9) & 1) << 5)); }
__host__ __device__ __forceinline__ void stage_rc(int b, int& R, int& C) { const int st = b / 1024, sb = b % 1024, swz = sb ^ (((sb >> 9) & 1) << 5); R = (st >> 1) * 16 + swz / 64; C = (st & 1) * 32 + (swz % 64) / 2; }
__host__ __device__ __forceinline__ int perm32(int rho) { const int n = rho >> 4, i = rho & 15; return 8 * (i >> 2) + 4 * n + (i & 3); }

struct Unit { int pm, pn; };
struct Gemm { const bf16_t* A; const bf16_t* Bt; int M, N, K; };

struct StaticOrder {
    int nM, nN, nwg, G, c;
    __host__ __device__ void init(int M, int N, int G_, int c_) { nM = M / BM; nN = N / BM; nwg = nM * nN; G = G_; c = c_; }
    __host__ __device__ bool next(int i, Unit& u) const {
        const long L = (long)i * G + c; if (L >= nwg) return false;
        int wgid = (int)L; { const int q = nwg / NXCD, r = nwg % NXCD, xcd = wgid % NXCD, off = wgid / NXCD; wgid = (xcd < r ? xcd * (q + 1) : r * (q + 1) + (xcd - r) * q) + off; }
        const int nig = WGM * nN, gid = wgid / nig, fm = gid * WGM, gsz = (nM - fm) < WGM ? (nM - fm) : WGM;
        u.pm = fm + ((wgid % nig) % gsz); u.pn = (wgid % nig) / gsz; return true;
    }
    __device__ __forceinline__ void a_ready(const Unit&) const {}
    __device__ __forceinline__ void done(const Unit&) const {}
};


typedef float f32x2 __attribute__((ext_vector_type(2))); typedef __bf16 bf16x2_t __attribute__((ext_vector_type(2)));
__device__ __forceinline__ unsigned cvt_pk_bf16(float lo, float hi) { const f32x2 v = {lo, hi}; const bf16x2_t b = __builtin_convertvector(v, bf16x2_t); return __builtin_bit_cast(unsigned, b); }

__device__ __forceinline__ float act_apply(int ACT, float v) {
    if (ACT == 2) { const float r = v > 0.f ? v : 0.f; return r * r; }
    if (ACT == 3) { return __builtin_amdgcn_rcpf(1.0f + __builtin_amdgcn_exp2f(-1.4426950408889634f * v)); }
    return v;
}
template <int ACT> struct EpiBf16 {
    static constexpr bool PERM = true, AFTER_DRAIN = false;
    bf16_t* O; int ldc;
    __device__ __forceinline__ void operator()(const f32x4 (&acc)[2][2][4][2], const Unit& u, int wr, int wc, int fr, int fq) const {
        const int row0 = u.pm * BM + wr * 64 + fr; const int col0 = u.pn * BM + wc * 32 + 8 * fq;
#pragma unroll
        for (int ai = 0; ai < 2; ++ai)
#pragma unroll
            for (int m = 0; m < 4; ++m) { bf16_t* rowp = O + (size_t)(row0 + ai * HALF + m * 16) * ldc + col0;
#pragma unroll
                for (int bj = 0; bj < 2; ++bj) { f32x4 v0 = acc[ai][bj][m][0], v1 = acc[ai][bj][m][1];
#pragma unroll
                    for (int e = 0; e < 4; ++e) { v0[e] = act_apply(ACT, v0[e]); v1[e] = act_apply(ACT, v1[e]); }
                    u32x4 w; w.x = cvt_pk_bf16(v0[0], v0[1]); w.y = cvt_pk_bf16(v0[2], v0[3]); w.z = cvt_pk_bf16(v1[0], v1[1]); w.w = cvt_pk_bf16(v1[2], v1[3]);
                    *(u32x4*)(rowp + bj * HALF) = w; } }
    }
};
struct EpiF32 {
    static constexpr bool PERM = false, AFTER_DRAIN = false;
    float* O; int ldc;
    __device__ __forceinline__ void operator()(const f32x4 (&acc)[2][2][4][2], const Unit& u, int wr, int wc, int fr, int fq) const {
        const int row0 = u.pm * BM + wr * 64 + fr; const int col0 = u.pn * BM + wc * 32 + 4 * fq;
#pragma unroll
        for (int ai = 0; ai < 2; ++ai)
#pragma unroll
            for (int m = 0; m < 4; ++m) { float* rowp = O + (size_t)(row0 + ai * HALF + m * 16) * ldc + col0;
#pragma unroll
                for (int bj = 0; bj < 2; ++bj)
#pragma unroll
                    for (int n = 0; n < 2; ++n) *(f32x4*)(rowp + bj * HALF + n * 16) = acc[ai][bj][m][n]; }
    }
};
template <class Epi, class Sched, bool ALIGN_EPI = false, bool SP2 = false>
__device__ __forceinline__ void gemm_phase(PG8_LAS unsigned char* lds, const Gemm g, const Sched& S, const Epi& E) {
    const int tid = threadIdx.x, wid = __builtin_amdgcn_readfirstlane(tid >> 6), lane = tid & 63, wr = wid >> 2, wc = wid & 3, fr = lane & 15, fq = lane >> 4;
    const int K = g.K, nt = K / BK;
    unsigned voffA[2], voffB[2];
#pragma unroll
    for (int i = 0; i < 2; ++i) { int R, C; stage_rc(tid * 16 + i * 8192, R, C); const int Rb = Epi::PERM ? ((R & ~31) + perm32(R & 31)) : R;
        voffA[i] = (unsigned)(R * K + C) * 2u; voffB[i] = (unsigned)(Rb * K + C) * 2u; }
    const size_t kstep = (size_t)(BK * 2);
    const size_t hstep = (size_t)HALF * K * 2;
    const size_t tstep = 2 * hstep;
    const unsigned ldsw = (unsigned)wid * 1024u;
    const int aoff = lds_byte(wr * 64 + fr, fq * 8), boff = lds_byte(wc * 32 + fr, fq * 8);
#define PG8_SA(b, h) (((b) * 2 + (h)) * HTB)
#define PG8_SB(b, h) ((4 + (b) * 2 + (h)) * HTB)
#define PG8_STAGE(bufoff, gbase, voff) do { _Pragma("unroll") for (int _i = 0; _i < 2; ++_i) \
        __builtin_amdgcn_global_load_lds((const unsigned*)((const char*)(gbase) + (voff)[_i]), (PG8_LAS unsigned*)(lds + (bufoff) + ldsw + _i * 8192), 16, 0, 0); } while (0)
#define PG8_LDA(dst, b, h) do { _Pragma("unroll") for (int m = 0; m < 4; ++m) _Pragma("unroll") for (int k = 0; k < 2; ++k) dst[m][k] = *(const PG8_LAS bf16x8*)(lds + PG8_SA(b, h) + aoff + m * 2048 + k * 1024); } while (0)
#define PG8_LDB(dst, b, h) do { _Pragma("unroll") for (int n = 0; n < 2; ++n) _Pragma("unroll") for (int k = 0; k < 2; ++k) dst[n][k] = *(const PG8_LAS bf16x8*)(lds + PG8_SB(b, h) + boff + n * 2048 + k * 1024); } while (0)
#define PG8_MMA(ai, bj, At, Bt) do { __builtin_amdgcn_s_setprio(1); _Pragma("unroll") for (int m = 0; m < 4; ++m) _Pragma("unroll") for (int n = 0; n < 2; ++n) _Pragma("unroll") for (int k = 0; k < 2; ++k) \
        acc[ai][bj][m][n] = __builtin_amdgcn_mfma_f32_16x16x32_bf16(Bt[n][k], At[m][k], acc[ai][bj][m][n], 0, 0, 0); __builtin_amdgcn_s_setprio(0); } while (0)
#define PG8_WAIT_V(n) asm volatile("s_waitcnt vmcnt(" #n ")" ::: "memory")
#define PG8_WAIT_L(n) asm volatile("s_waitcnt lgkmcnt(" #n ")" ::: "memory")
#define PG8_BAR __builtin_amdgcn_s_barrier()
#define PG8_SCHED __builtin_amdgcn_sched_barrier(0)
    Unit cur, nxt; int ui = 0;
    if (!S.next(0, cur)) return;
    f32x4 acc[2][2][4][2];
#pragma unroll
    for (int a = 0; a < 2; ++a)
#pragma unroll
        for (int b = 0; b < 2; ++b)
#pragma unroll
            for (int m = 0; m < 4; ++m)
#pragma unroll
                for (int n = 0; n < 2; ++n) acc[a][b][m][n] = (f32x4){0.f, 0.f, 0.f, 0.f};
    bf16x8 At[4][2], B0[2][2], B1[2][2];
    const char* cA = (const char*)g.A + (size_t)cur.pm * tstep; const char* cB = (const char*)g.Bt + (size_t)cur.pn * tstep;
    S.a_ready(cur);
    if constexpr (SP2) {
        PG8_STAGE(PG8_SB(0, 0), cB, voffB); PG8_STAGE(PG8_SB(0, 1), cB + hstep, voffB); PG8_STAGE(PG8_SA(0, 0), cA, voffA); PG8_STAGE(PG8_SA(0, 1), cA + hstep, voffA);
        if (wr == 1) PG8_BAR;
        PG8_WAIT_V(2); PG8_BAR;
        PG8_STAGE(PG8_SB(1, 0), cB + kstep, voffB); PG8_STAGE(PG8_SA(1, 0), cA + kstep, voffA); PG8_STAGE(PG8_SB(1, 1), cB + hstep + kstep, voffB);
        PG8_WAIT_V(6); PG8_BAR;
    } else {
        PG8_STAGE(PG8_SB(0, 0), cB, voffB); PG8_STAGE(PG8_SA(0, 0), cA, voffA); PG8_STAGE(PG8_SB(0, 1), cB + hstep, voffB); PG8_STAGE(PG8_SA(0, 1), cA + hstep, voffA);
        if (wr == 1) PG8_BAR;
        PG8_WAIT_V(4); PG8_BAR;
        PG8_STAGE(PG8_SB(1, 0), cB + kstep, voffB); PG8_STAGE(PG8_SA(1, 0), cA + kstep, voffA); PG8_STAGE(PG8_SB(1, 1), cB + hstep + kstep, voffB);
        PG8_WAIT_V(6); PG8_BAR;
    }
    for (;;) {
        const bool has_next = S.next(ui + 1, nxt);
        const char* nA = has_next ? (const char*)g.A + (size_t)nxt.pm * tstep : cA; const char* nB = has_next ? (const char*)g.Bt + (size_t)nxt.pn * tstep : cB;
        for (int t = 0; t < nt; t += 2) {
            const bool last = (t == nt - 2);
            const char* a1 = cA + (size_t)(t + 1) * kstep;
            const char* a2 = last ? nA : cA + (size_t)(t + 2) * kstep; const char* b2 = last ? nB : cB + (size_t)(t + 2) * kstep;
            const char* a3 = a2 + kstep; const char* b3 = b2 + kstep;
            if (last && has_next) S.a_ready(nxt);
            if constexpr (SP2) {
            PG8_LDB(B0, 0, 0); PG8_LDB(B1, 0, 1); PG8_SCHED; PG8_LDA(At, 0, 0); PG8_STAGE(PG8_SA(1, 1), a1 + hstep, voffA);
            PG8_WAIT_V(8); PG8_WAIT_L(0); PG8_BAR; PG8_MMA(0, 0, At, B0); PG8_MMA(0, 1, At, B1); PG8_BAR; PG8_SCHED;
            PG8_LDA(At, 0, 1); PG8_STAGE(PG8_SB(0, 0), b2, voffB); PG8_STAGE(PG8_SB(0, 1), b2 + hstep, voffB); PG8_STAGE(PG8_SA(0, 0), a2, voffA);
            PG8_WAIT_V(8); PG8_WAIT_L(0); PG8_BAR; PG8_MMA(1, 0, At, B0); PG8_MMA(1, 1, At, B1); PG8_BAR; PG8_SCHED;
            PG8_LDB(B0, 1, 0); PG8_LDB(B1, 1, 1); PG8_SCHED; PG8_LDA(At, 1, 0); PG8_STAGE(PG8_SA(0, 1), a2 + hstep, voffA);
            PG8_WAIT_V(8); PG8_WAIT_L(0); PG8_BAR; PG8_MMA(0, 0, At, B0); PG8_MMA(0, 1, At, B1); PG8_BAR; PG8_SCHED;
            PG8_LDA(At, 1, 1); PG8_STAGE(PG8_SB(1, 0), b3, voffB); PG8_STAGE(PG8_SB(1, 1), b3 + hstep, voffB); PG8_STAGE(PG8_SA(1, 0), a3, voffA);
            PG8_WAIT_V(8); PG8_WAIT_L(0); PG8_BAR; PG8_MMA(1, 0, At, B0); PG8_MMA(1, 1, At, B1); PG8_BAR; PG8_SCHED;
            } else {
            PG8_LDB(B0, 0, 0); PG8_SCHED; PG8_LDA(At, 0, 0); PG8_STAGE(PG8_SA(1, 1), a1 + hstep, voffA);
            PG8_WAIT_L(8); PG8_BAR; PG8_WAIT_L(0); PG8_MMA(0, 0, At, B0); PG8_BAR; PG8_SCHED;
            PG8_LDB(B1, 0, 1); PG8_STAGE(PG8_SB(0, 0), b2, voffB);
            PG8_BAR; PG8_WAIT_L(0); PG8_MMA(0, 1, At, B1); PG8_BAR;
            PG8_LDA(At, 0, 1); PG8_STAGE(PG8_SA(0, 0), a2, voffA);
            PG8_BAR; PG8_WAIT_L(0); PG8_MMA(1, 0, At, B0); PG8_BAR; PG8_SCHED;
            PG8_STAGE(PG8_SB(0, 1), b2 + hstep, voffB);
            PG8_WAIT_V(6); PG8_BAR; PG8_MMA(1, 1, At, B1); PG8_BAR;
            PG8_LDB(B0, 1, 0); PG8_SCHED; PG8_LDA(At, 1, 0); PG8_STAGE(PG8_SA(0, 1), a2 + hstep, voffA);
            PG8_WAIT_L(8); PG8_BAR; PG8_WAIT_L(0); PG8_MMA(0, 0, At, B0); PG8_BAR; PG8_SCHED;
            PG8_LDB(B1, 1, 1); PG8_STAGE(PG8_SB(1, 0), b3, voffB);
            PG8_BAR; PG8_WAIT_L(0); PG8_MMA(0, 1, At, B1); PG8_BAR;
            PG8_LDA(At, 1, 1); PG8_STAGE(PG8_SA(1, 0), a3, voffA);
            PG8_BAR; PG8_WAIT_L(0); PG8_MMA(1, 0, At, B0); PG8_BAR; PG8_SCHED;
            PG8_STAGE(PG8_SB(1, 1), b3 + hstep, voffB);
            PG8_WAIT_V(6); PG8_BAR; PG8_MMA(1, 1, At, B1); PG8_BAR;
            }
        }
        if constexpr (ALIGN_EPI) { if (wr == 0) PG8_BAR; }
        if constexpr (!Epi::AFTER_DRAIN) { E(acc, cur, wr, wc, fr, fq); S.done(cur); }
        if (!has_next) break;
#pragma unroll
        for (int a = 0; a < 2; ++a)
#pragma unroll
            for (int b = 0; b < 2; ++b)
#pragma unroll
                for (int m = 0; m < 4; ++m)
#pragma unroll
                    for (int n = 0; n < 2; ++n) acc[a][b][m][n] = (f32x4){0.f, 0.f, 0.f, 0.f};
        cur = nxt; cA = nA; cB = nB; ++ui;
        if constexpr (ALIGN_EPI) { if (wr == 1) PG8_BAR; }
    }
    PG8_WAIT_V(0);
    if constexpr (!ALIGN_EPI) { if (wr == 0) PG8_BAR; }
    PG8_BAR;
    if constexpr (Epi::AFTER_DRAIN) { E.fused(acc, cur, wr, wc, fr, fq, lds, wid, lane); S.done(cur); }
#undef PG8_SA
#undef PG8_SB
#undef PG8_STAGE
#undef PG8_LDA
#undef PG8_LDB
#undef PG8_MMA
#undef PG8_WAIT_V
#undef PG8_WAIT_L
#undef PG8_BAR
#undef PG8_SCHED
}
}
#define GAS __attribute__((address_space(1)))
#define LAS __attribute__((address_space(3)))
typedef unsigned short bf16;
typedef float f32x2v __attribute__((ext_vector_type(2)));
typedef unsigned v4u __attribute__((ext_vector_type(4)));
typedef float f32x4 __attribute__((ext_vector_type(4)));
typedef short bf16x8 __attribute__((ext_vector_type(8)));
typedef GAS unsigned gu32;
typedef GAS unsigned long long gu64;
#define RLX_AGENT __ATOMIC_RELAXED, __HIP_MEMORY_SCOPE_AGENT
#define LDS_WAIT() asm volatile("s_waitcnt lgkmcnt(0)" ::: "memory")
#define VM_WAIT() asm volatile("s_waitcnt vmcnt(0)" ::: "memory")
__device__ __forceinline__ unsigned long long rt() { return __builtin_amdgcn_s_memrealtime(); }
__device__ __forceinline__ unsigned f2bf(float f) { unsigned u = __builtin_bit_cast(unsigned, f); return (u + 0x7fffu + ((u >> 16) & 1u)) >> 16; }
__device__ __forceinline__ unsigned pk2(float lo, float hi) { return f2bf(lo) | (f2bf(hi) << 16); }

#define XB_TMO      128
#define XB_XCNT(j)  (256  + 64 * (j))
#define XB_XSUB(j)  (1280 + 64 * (j))
#define XB_XGEN(j)  (2304 + 64 * (j))
#define XB_TOP      3328
#define XB_TOPGEN   3392
#define XCD_BAR_WORDS 3456
#define XB_SPIN_CAP (1u << 18)

__device__ __forceinline__ unsigned xb_ld(unsigned* p)              { return __hip_atomic_load(p, __ATOMIC_RELAXED, __HIP_MEMORY_SCOPE_AGENT); }
__device__ __forceinline__ unsigned xb_add(unsigned* p, unsigned v) { return __hip_atomic_fetch_add(p, v, __ATOMIC_RELAXED, __HIP_MEMORY_SCOPE_AGENT); }
__device__ __forceinline__ unsigned xb_xcc_id() { return (unsigned)__builtin_amdgcn_s_getreg((3 << 11) | 20) & 0xFu; }
#define XB_SPIN(cond, bar) do { unsigned _sp = 0; while (cond) { __builtin_amdgcn_s_sleep(1); \
    if ((++_sp & 255u) == 0u) { if (xb_ld(&(bar)[XB_TMO])) break; if (_sp > XB_SPIN_CAP) { atomicAdd(&(bar)[XB_TMO], 1u); break; } } } } while (0)

struct XcdBarrier {
    unsigned* bar; unsigned x;
    volatile LAS unsigned* st;
};

__device__ __forceinline__ XcdBarrier xcd_barrier_post(unsigned* bar, volatile LAS unsigned* st) {
    XcdBarrier b; b.bar = bar; b.x = xb_xcc_id(); b.st = st;
    if (threadIdx.x == 0) (void)xb_add(&bar[XB_XCNT(b.x)], 1u);
    return b;
}
__device__ __forceinline__ void xcd_barrier_complete(unsigned* bar, unsigned x, unsigned& nloc, unsigned& nx) {
    const unsigned G = gridDim.x * gridDim.y * gridDim.z;
    unsigned sum, cnt, mine, sp = 0u;
    for (;;) {
        sum = 0u; cnt = 0u; mine = 0u;
#pragma unroll
        for (unsigned j = 0; j < 16; ++j) { const unsigned c = xb_ld(&bar[XB_XCNT(j)]); sum += c; cnt += (c > 0u) ? 1u : 0u; mine = (j == x) ? c : mine; }
        if (sum == G) break;
        __builtin_amdgcn_s_sleep(1);
        if ((++sp & 255u) == 0u) { if (xb_ld(&bar[XB_TMO])) break; if (sp > XB_SPIN_CAP) { atomicAdd(&bar[XB_TMO], 1u); break; } }
    }
    nloc = mine > 0u ? mine : 1u; nx = cnt > 0u ? cnt : 1u;
}

__device__ __forceinline__ void xcd_barrier(const XcdBarrier& b) {
    asm volatile("s_waitcnt vmcnt(0)" ::: "memory");
    __syncthreads();
    if (threadIdx.x == 0) {
        unsigned* bar = b.bar;
        __builtin_amdgcn_s_waitcnt(0);
        unsigned nloc = b.st[0], nx = b.st[1];
        if (nloc == 0u) { xcd_barrier_complete(bar, b.x, nloc, nx); b.st[0] = nloc; b.st[1] = nx; }
        const unsigned old = xb_add(&bar[XB_XSUB(b.x)], 1u);
        const unsigned gen = old / nloc;
        if (old + 1u == (gen + 1u) * nloc) {
            __builtin_amdgcn_fence(__ATOMIC_RELEASE, "agent");
            asm volatile("s_waitcnt vmcnt(0)" ::: "memory");
            const unsigned og = xb_add(&bar[XB_TOP], 1u);
            const unsigned tg = og / nx;
            if (og + 1u == (tg + 1u) * nx) xb_add(&bar[XB_TOPGEN], 1u);
            else XB_SPIN(xb_ld(&bar[XB_TOPGEN]) == tg, bar);
            __builtin_amdgcn_fence(__ATOMIC_ACQUIRE, "agent");
            xb_add(&bar[XB_XGEN(b.x)], 1u);
            asm volatile("s_waitcnt vmcnt(0)" ::: "memory");
        } else {
            XB_SPIN(xb_ld(&bar[XB_XGEN(b.x)]) == gen, bar);
            __builtin_amdgcn_fence(__ATOMIC_ACQUIRE, "agent");
            asm volatile("s_waitcnt vmcnt(0)" ::: "memory");
        }
    }
    __syncthreads();
}

constexpr int NWAVES = 8;
constexpr int BATCH = 8, SEQ = 4096, DM = 1024, M = BATCH * SEQ;
constexpr int NPROJ = 2816, NPROJ_SRC = 2824;
constexpr int FF = 4096, PLE = 256, NH = 8, HD = 64, SSD_N = 128, CONVC = 768, CHUNK = 128, NCHUNK = SEQ / CHUNK;
constexpr float EPS = 1e-6f;
constexpr float QSCALE = 0.125f * 1.4426950408889634f;

constexpr size_t MiB = 1u << 20;
constexpr size_t WS_CTL = 0, CTL_ZERO_BYTES = 1 * MiB;
constexpr size_t WS_DT = 1 * MiB;
constexpr size_t WS_TAB = 8 * MiB;
constexpr size_t WS_WIN = 16 * MiB, WS_WOUT = 22 * MiB, WS_WUP = 24 * MiB, WS_WDN = 32 * MiB, WS_WG = 40 * MiB, WS_WP = 42 * MiB;
constexpr size_t WS_XN = 48 * MiB;
constexpr size_t WS_PB = 112 * MiB;
constexpr size_t WS_H = 128 * MiB;
constexpr size_t WS_QKV = 128 * MiB;
constexpr size_t WS_Z = 224 * MiB;
constexpr size_t WS_XBC = 256 * MiB;
constexpr size_t WS_MIX = 256 * MiB;
constexpr size_t WS_PROJ = 320 * MiB;
constexpr size_t WS_XC = 384 * MiB;
constexpr size_t WS_Y = 128 * MiB;
constexpr size_t WS_T = 384 * MiB;
constexpr size_t WS_SIG = 128 * MiB;
constexpr size_t WS_END = 512 * MiB;
constexpr int CW_TMO = 0, CW_CODE = 1, CW_BAR = 4096;

constexpr int RING_OFF = 0, RING_BYTES = 131072;
constexpr int LDSCTL_OFF = RING_BYTES, MISC_OFF = LDSCTL_OFF + 320;
constexpr int LDS_BYTES = 147456;

struct Args { const void* in[20]; float* out; unsigned char* ws; int ph_lo, ph_hi; float inv_freq[32]; };
struct Frame {
    LAS unsigned char* lds;
    volatile LAS unsigned* MISC;
    gu32* ctl;
    int tid, lane, wave, vcu, G;
};
typedef unsigned v2u __attribute__((ext_vector_type(2)));
__device__ __forceinline__ float bf2f(unsigned short b) { return __builtin_bit_cast(float, (unsigned)b << 16); }
__device__ __forceinline__ float bflo(unsigned w) { return __builtin_bit_cast(float, w << 16); }
__device__ __forceinline__ float bfhi(unsigned w) { return __builtin_bit_cast(float, w & 0xffff0000u); }
__device__ __forceinline__ float wave_sum(float v) {
#pragma unroll
    for (int o = 1; o < 64; o <<= 1) v += __shfl_xor(v, o);
    return v;
}
__device__ __forceinline__ float silu_f(float v) { return v / (1.0f + __expf(-v)); }

__device__ __forceinline__ void p0_transpose_item(const float* W, int K, int ldw, int ncols, bf16* WT, LAS float* scr, int item, int lane) {
    const int nblk = ncols / 32, kb = item / nblk, nb = item % nblk, k0 = 64 * kb, n0 = 32 * nb;
#pragma unroll 8
    for (int i = 0; i < 32; ++i) { const int kk = 2 * i + (lane >> 5); scr[kk * 33 + (lane & 31)] = W[(size_t)(k0 + kk) * ldw + n0 + (lane & 31)]; }
    LDS_WAIT(); asm volatile("" ::: "memory");
    const int c = lane & 7;
#pragma unroll
    for (int j = 0; j < 4; ++j) { const int n = (lane >> 3) + 8 * j; const LAS float* s = scr + (8 * c) * 33 + n;
        v4u o; o.x = pk2(s[0 * 33], s[1 * 33]); o.y = pk2(s[2 * 33], s[3 * 33]); o.z = pk2(s[4 * 33], s[5 * 33]); o.w = pk2(s[6 * 33], s[7 * 33]);
        *(GAS v4u*)(WT + (size_t)(n0 + n) * K + k0 + 8 * c) = o; }
    LDS_WAIT(); asm volatile("" ::: "memory");
}
__device__ __forceinline__ void p0_prologue(Frame& F, const Args& A) {
    unsigned char* ws = A.ws;
    LAS float* scr = (LAS float*)(F.lds + RING_OFF + F.wave * 16384);
    const int gw = F.vcu * NWAVES + F.wave, NGW = F.G * NWAVES;
    const float* w_in = (const float*)A.in[5]; const float* w_out = (const float*)A.in[12]; const float* w_up = (const float*)A.in[15];
    const float* w_dn = (const float*)A.in[16]; const float* w_g = (const float*)A.in[17]; const float* w_p = (const float*)A.in[18];
    constexpr int I_IN = (DM / 64) * (NPROJ / 32), I_OUT = (DM / 64) * (DM / 32), I_UP = (DM / 64) * (FF / 32), I_DN = (FF / 64) * (DM / 32), I_G = I_OUT, I_P = (PLE / 64) * (DM / 32);
    constexpr int NITEMS = I_IN + I_OUT + I_UP + I_DN + I_G + I_P;
    for (int it = gw; it < NITEMS; it += NGW) {
        int r = it;
        if (r < I_IN) { p0_transpose_item(w_in, DM, NPROJ_SRC, NPROJ, (bf16*)(ws + WS_WIN), scr, r, F.lane); continue; } r -= I_IN;
        if (r < I_OUT) { p0_transpose_item(w_out, DM, DM, DM, (bf16*)(ws + WS_WOUT), scr, r, F.lane); continue; } r -= I_OUT;
        if (r < I_UP) { p0_transpose_item(w_up, DM, FF, FF, (bf16*)(ws + WS_WUP), scr, r, F.lane); continue; } r -= I_UP;
        if (r < I_DN) { p0_transpose_item(w_dn, FF, DM, DM, (bf16*)(ws + WS_WDN), scr, r, F.lane); continue; } r -= I_DN;
        if (r < I_G) { p0_transpose_item(w_g, DM, DM, DM, (bf16*)(ws + WS_WG), scr, r, F.lane); continue; } r -= I_G;
        p0_transpose_item(w_p, PLE, DM, DM, (bf16*)(ws + WS_WP), scr, r, F.lane);
    }
    const float* x = (const float*)A.in[0]; const float* pin = (const float*)A.in[1]; const int* pos = (const int*)A.in[2];
    const float* g_pre = (const float*)A.in[3]; const float* dt_bias = (const float*)A.in[8];
    bf16* XN = (bf16*)(ws + WS_XN); bf16* PB = (bf16*)(ws + WS_PB); float* DT = (float*)(ws + WS_DT); float* TAB = (float*)(ws + WS_TAB);
    const int lane = F.lane;
    const float myfreq = A.inv_freq[lane & 31];
    for (int m = gw; m < M; m += NGW) {
        const GAS f32x4* xr = (const GAS f32x4*)(x + (size_t)m * DM) + lane;
        const GAS f32x4* gr = (const GAS f32x4*)g_pre + lane;
        f32x4 v[4]; float ss = 0.f;
#pragma unroll
        for (int j = 0; j < 4; ++j) { v[j] = xr[64 * j]; ss += (v[j].x * v[j].x + v[j].y * v[j].y) + (v[j].z * v[j].z + v[j].w * v[j].w); }
        const float rstd = 1.0f / sqrtf(wave_sum(ss) * (1.f / DM) + EPS);
        GAS unsigned long long* o8 = (GAS unsigned long long*)(XN + (size_t)m * DM) + lane;
        float dacc[8];
#pragma unroll
        for (int q = 0; q < 8; ++q) dacc[q] = 0.f;
#pragma unroll
        for (int j = 0; j < 4; ++j) {
            const f32x4 g = gr[64 * j]; v[j] = v[j] * rstd * g;
            o8[64 * j] = (unsigned long long)pk2(v[j].x, v[j].y) | ((unsigned long long)pk2(v[j].z, v[j].w) << 32);
#pragma unroll
            for (int e = 0; e < 4; ++e) {
                const int k = 256 * j + 4 * lane + e;
                const GAS f32x4* wp = (const GAS f32x4*)(w_in + (size_t)k * NPROJ_SRC + NPROJ);
                const f32x4 w0 = wp[0], w1 = wp[1]; const float uv = v[j][e];
                dacc[0] += uv * w0.x; dacc[1] += uv * w0.y; dacc[2] += uv * w0.z; dacc[3] += uv * w0.w;
                dacc[4] += uv * w1.x; dacc[5] += uv * w1.y; dacc[6] += uv * w1.z; dacc[7] += uv * w1.w;
            }
        }
#pragma unroll
        for (int q = 0; q < 8; ++q) dacc[q] = wave_sum(dacc[q]);
        if (lane < 8) {
            float d = dacc[0];
#pragma unroll
            for (int q = 1; q < 8; ++q) d = (lane == q) ? dacc[q] : d;
            d += dt_bias[lane];
            const float sp = d > 20.f ? d : log1pf(expf(d));
            DT[(size_t)m * 8 + lane] = sp;
        }
        if (lane < 32) {
            const float ang = (float)pos[m] * myfreq; float sn, cs; sincosf(ang, &sn, &cs);
            *(GAS f32x2v*)(TAB + ((size_t)m * 32 + lane) * 2) = (f32x2v){cs, sn};
        }
        { const f32x4 pv = *((const GAS f32x4*)(pin + (size_t)m * PLE) + lane);
          *((GAS unsigned long long*)(PB + (size_t)m * PLE) + lane) = (unsigned long long)pk2(pv.x, pv.y) | ((unsigned long long)pk2(pv.z, pv.w) << 32); }
    }
}

__device__ __forceinline__ void p_split(Frame& F, const Args& A) {
    unsigned char* ws = A.ws;
    const bf16* PROJ = (const bf16*)(ws + WS_PROJ); bf16* QKV = (bf16*)(ws + WS_QKV); bf16* Z = (bf16*)(ws + WS_Z); bf16* XBC = (bf16*)(ws + WS_XBC);
    const float* TAB = (const float*)(ws + WS_TAB);
    const long gt = (long)F.vcu * (NWAVES * 64) + F.tid, NT = (long)F.G * NWAVES * 64;
    for (long it = gt; it < (long)M * 288; it += NT) {
        const int row = (int)(it / 288), c = (int)(it % 288);
        const bf16* src = PROJ + (size_t)row * NPROJ;
        if (c < 64) {
            const int hd = c >> 2, i0 = 8 * (c & 3); const float sc = hd < 8 ? QSCALE : 1.0f;
            const v4u a = *(const GAS v4u*)(src + hd * 64 + i0), b = *(const GAS v4u*)(src + hd * 64 + 32 + i0);
            const GAS f32x4* tb = (const GAS f32x4*)(TAB + ((size_t)row * 32 + i0) * 2);
            float t1[8], t2[8], o1[8], o2[8];
            t1[0] = bflo(a.x); t1[1] = bfhi(a.x); t1[2] = bflo(a.y); t1[3] = bfhi(a.y); t1[4] = bflo(a.z); t1[5] = bfhi(a.z); t1[6] = bflo(a.w); t1[7] = bfhi(a.w);
            t2[0] = bflo(b.x); t2[1] = bfhi(b.x); t2[2] = bflo(b.y); t2[3] = bfhi(b.y); t2[4] = bflo(b.z); t2[5] = bfhi(b.z); t2[6] = bflo(b.w); t2[7] = bfhi(b.w);
#pragma unroll
            for (int e2 = 0; e2 < 4; ++e2) { const f32x4 cs = tb[e2];
                o1[2 * e2] = (t1[2 * e2] * cs.x - t2[2 * e2] * cs.y) * sc; o2[2 * e2] = (t2[2 * e2] * cs.x + t1[2 * e2] * cs.y) * sc;
                o1[2 * e2 + 1] = (t1[2 * e2 + 1] * cs.z - t2[2 * e2 + 1] * cs.w) * sc; o2[2 * e2 + 1] = (t2[2 * e2 + 1] * cs.z + t1[2 * e2 + 1] * cs.w) * sc; }
            v4u w1, w2; w1.x = pk2(o1[0], o1[1]); w1.y = pk2(o1[2], o1[3]); w1.z = pk2(o1[4], o1[5]); w1.w = pk2(o1[6], o1[7]);
            w2.x = pk2(o2[0], o2[1]); w2.y = pk2(o2[2], o2[3]); w2.z = pk2(o2[4], o2[5]); w2.w = pk2(o2[6], o2[7]);
            bf16* dst = QKV + (size_t)row * 1536 + hd * 64 + i0;
            *(GAS v4u*)dst = w1; *(GAS v4u*)(dst + 32) = w2;
        } else if (c < 128) {
            const int col = 1024 + 8 * (c - 64);
            *(GAS v4u*)(QKV + (size_t)row * 1536 + col) = *(const GAS v4u*)(src + col);
        } else if (c < 192) {
            const int cc = 8 * (c - 128); const v4u a = *(const GAS v4u*)(src + 1536 + cc); v4u w;
            w.x = pk2(silu_f(bflo(a.x)), silu_f(bfhi(a.x))); w.y = pk2(silu_f(bflo(a.y)), silu_f(bfhi(a.y)));
            w.z = pk2(silu_f(bflo(a.z)), silu_f(bfhi(a.z))); w.w = pk2(silu_f(bflo(a.w)), silu_f(bfhi(a.w)));
            *(GAS v4u*)(Z + (size_t)row * 512 + cc) = w;
        } else {
            const int cc = 8 * (c - 192);
            *(GAS v4u*)(XBC + (size_t)row * CONVC + cc) = *(const GAS v4u*)(src + 2048 + cc);
        }
    }
}

__device__ __forceinline__ void p_conv_naive(Frame& F, const Args& A) {
    unsigned char* ws = A.ws;
    const bf16* XBC = (const bf16*)(ws + WS_XBC); float* XC = (float*)(ws + WS_XC);
    const float* cw = (const float*)A.in[6]; const float* cb = (const float*)A.in[7];
    const long gt = (long)F.vcu * (NWAVES * 64) + F.tid, NT = (long)F.G * NWAVES * 64;
    for (long it = gt; it < (long)M * 96; it += NT) {
        const int row = (int)(it / 96), col = 8 * (int)(it % 96), t = row & (SEQ - 1);
        float acc[8];
#pragma unroll
        for (int e = 0; e < 8; ++e) acc[e] = cb[col + e];
#pragma unroll
        for (int w = 0; w < 4; ++w) {
            if (t - 3 + w >= 0) {
                const v4u a = *(const GAS v4u*)(XBC + (size_t)(row - 3 + w) * CONVC + col);
                const float* wp = cw + w * CONVC + col;
                acc[0] += bflo(a.x) * wp[0]; acc[1] += bfhi(a.x) * wp[1]; acc[2] += bflo(a.y) * wp[2]; acc[3] += bfhi(a.y) * wp[3];
                acc[4] += bflo(a.z) * wp[4]; acc[5] += bfhi(a.z) * wp[5]; acc[6] += bflo(a.w) * wp[6]; acc[7] += bfhi(a.w) * wp[7];
            }
        }
        f32x4 o0, o1; o0.x = silu_f(acc[0]); o0.y = silu_f(acc[1]); o0.z = silu_f(acc[2]); o0.w = silu_f(acc[3]);
        o1.x = silu_f(acc[4]); o1.y = silu_f(acc[5]); o1.z = silu_f(acc[6]); o1.w = silu_f(acc[7]);
        GAS f32x4* dst = (GAS f32x4*)(XC + (size_t)row * CONVC + col); dst[0] = o0; dst[1] = o1;
    }
}

__device__ __forceinline__ void p_attn_naive(Frame& F, const Args& A) {
    unsigned char* ws = A.ws;
    const bf16* QKV = (const bf16*)(ws + WS_QKV); bf16* MIX = (bf16*)(ws + WS_MIX);
    const long gt = (long)F.vcu * (NWAVES * 64) + F.tid, NT = (long)F.G * NWAVES * 64;
    for (long it = gt; it < (long)M * NH; it += NT) {
        const int h = (int)(it & 7), row = (int)(it >> 3), b = row >> 12, t = row & (SEQ - 1);
        float q[64], o[64];
        { const GAS v4u* qp = (const GAS v4u*)(QKV + (size_t)row * 1536 + h * 64);
#pragma unroll
          for (int c = 0; c < 8; ++c) { const v4u a = qp[c]; q[8 * c] = bflo(a.x); q[8 * c + 1] = bfhi(a.x); q[8 * c + 2] = bflo(a.y); q[8 * c + 3] = bfhi(a.y);
              q[8 * c + 4] = bflo(a.z); q[8 * c + 5] = bfhi(a.z); q[8 * c + 6] = bflo(a.w); q[8 * c + 7] = bfhi(a.w); } }
#pragma unroll
        for (int i = 0; i < 64; ++i) o[i] = 0.f;
        float mx = -INFINITY, l = 0.f;
        for (int br = 0; br < 3; ++br) {
            const int d = br == 0 ? 1 : (br == 1 ? 4 : 16);
            for (int j = 0; j <= 128; ++j) {
                const int tk = t - d * j; if (tk < 0) break;
                const size_t krow = (size_t)(b * SEQ + tk);
                const GAS v4u* kp = (const GAS v4u*)(QKV + krow * 1536 + 512 + h * 64);
                const GAS v4u* vp = (const GAS v4u*)(QKV + krow * 1536 + 1024 + h * 64);
                float s = 0.f;
#pragma unroll
                for (int c = 0; c < 8; ++c) { const v4u a = kp[c];
                    s += q[8 * c] * bflo(a.x) + q[8 * c + 1] * bfhi(a.x) + q[8 * c + 2] * bflo(a.y) + q[8 * c + 3] * bfhi(a.y)
                       + q[8 * c + 4] * bflo(a.z) + q[8 * c + 5] * bfhi(a.z) + q[8 * c + 6] * bflo(a.w) + q[8 * c + 7] * bfhi(a.w); }
                if (s > mx) { const float f = exp2f(mx - s); l *= f;
#pragma unroll
                    for (int i = 0; i < 64; ++i) o[i] *= f;
                    mx = s; }
                const float p = exp2f(s - mx); l += p;
#pragma unroll
                for (int c = 0; c < 8; ++c) { const v4u a = vp[c];
                    o[8 * c] += p * bflo(a.x); o[8 * c + 1] += p * bfhi(a.x); o[8 * c + 2] += p * bflo(a.y); o[8 * c + 3] += p * bfhi(a.y);
                    o[8 * c + 4] += p * bflo(a.z); o[8 * c + 5] += p * bfhi(a.z); o[8 * c + 6] += p * bflo(a.w); o[8 * c + 7] += p * bfhi(a.w); }
            }
        }
        const float rl = 1.0f / l;
        GAS v4u* dst = (GAS v4u*)(MIX + (size_t)row * 1024 + h * 64);
#pragma unroll
        for (int c = 0; c < 8; ++c) { v4u w; w.x = pk2(o[8 * c] * rl, o[8 * c + 1] * rl); w.y = pk2(o[8 * c + 2] * rl, o[8 * c + 3] * rl);
            w.z = pk2(o[8 * c + 4] * rl, o[8 * c + 5] * rl); w.w = pk2(o[8 * c + 6] * rl, o[8 * c + 7] * rl); dst[c] = w; }
    }
}

__device__ __forceinline__ void p_ssd_naive(Frame& F, const Args& A) {
    unsigned char* ws = A.ws;
    const float* XC = (const float*)(ws + WS_XC); const float* DT = (const float*)(ws + WS_DT); float* Y = (float*)(ws + WS_Y);
    const float* a_log = (const float*)A.in[9]; const float* d_skip = (const float*)A.in[10];
    const int gw = F.vcu * NWAVES + F.wave, NGW = F.G * NWAVES, lane = F.lane;
    for (int it = gw; it < BATCH * NH * HD; it += NGW) {
        const int b = it >> 9, h = (it >> 6) & 7, p = it & 63;
        const float Ah = -expf(a_log[h]), Dh = d_skip[h];
        float h0 = 0.f, h1 = 0.f;
        for (int t0 = 0; t0 < SEQ; t0 += 8) {
            float dtv[8], xv[8]; f32x2v Bv[8], Cv[8];
#pragma unroll
            for (int u = 0; u < 8; ++u) { const size_t row = (size_t)b * SEQ + t0 + u;
                dtv[u] = DT[row * 8 + h]; xv[u] = XC[row * CONVC + h * 64 + p];
                Bv[u] = *(const GAS f32x2v*)(XC + row * CONVC + 512 + 2 * lane); Cv[u] = *(const GAS f32x2v*)(XC + row * CONVC + 640 + 2 * lane); }
#pragma unroll
            for (int u = 0; u < 8; ++u) { const float dec = expf(dtv[u] * Ah), xdt = xv[u] * dtv[u];
                h0 = dec * h0 + Bv[u].x * xdt; h1 = dec * h1 + Bv[u].y * xdt;
                const float y = wave_sum(Cv[u].x * h0 + Cv[u].y * h1);
                if (lane == 0) Y[((size_t)b * SEQ + t0 + u) * 512 + h * 64 + p] = y + Dh * xv[u]; }
        }
    }
}

__device__ __forceinline__ void p_gate_naive(Frame& F, const Args& A) {
    unsigned char* ws = A.ws;
    const float* Y = (const float*)(ws + WS_Y); const bf16* Z = (const bf16*)(ws + WS_Z); bf16* MIX = (bf16*)(ws + WS_MIX);
    const float* g = (const float*)A.in[11];
    const int gw = F.vcu * NWAVES + F.wave, NGW = F.G * NWAVES, lane = F.lane;
    for (int m = gw; m < M; m += NGW) {
        const GAS f32x4* yp = (const GAS f32x4*)(Y + (size_t)m * 512 + 8 * lane); const f32x4 y0 = yp[0], y1 = yp[1];
        const v4u z = *(const GAS v4u*)(Z + (size_t)m * 512 + 8 * lane);
        float v[8]; v[0] = y0.x * bflo(z.x); v[1] = y0.y * bfhi(z.x); v[2] = y0.z * bflo(z.y); v[3] = y0.w * bfhi(z.y);
        v[4] = y1.x * bflo(z.z); v[5] = y1.y * bfhi(z.z); v[6] = y1.z * bflo(z.w); v[7] = y1.w * bfhi(z.w);
        float ss = 0.f;
#pragma unroll
        for (int e = 0; e < 8; ++e) ss += v[e] * v[e];
        const float rstd = 1.0f / sqrtf(wave_sum(ss) * (1.f / 512.f) + EPS);
        const GAS f32x4* gp = (const GAS f32x4*)(g + 8 * lane); const f32x4 g0 = gp[0], g1 = gp[1];
        v4u w; w.x = pk2(v[0] * rstd * g0.x, v[1] * rstd * g0.y); w.y = pk2(v[2] * rstd * g0.z, v[3] * rstd * g0.w);
        w.z = pk2(v[4] * rstd * g1.x, v[5] * rstd * g1.y); w.w = pk2(v[6] * rstd * g1.z, v[7] * rstd * g1.w);
        *(GAS v4u*)(MIX + (size_t)m * 1024 + 512 + 8 * lane) = w;
    }
}

template <int MODE> __device__ __forceinline__ void p_rows(Frame& F, const Args& A, const float* ga, const float* gb) {
    unsigned char* ws = A.ws;
    const float* T = (const float*)(ws + WS_T); const float* x = (const float*)A.in[0]; float* out = A.out;
    bf16* XN = (bf16*)(ws + WS_XN); const bf16* SIG = (const bf16*)(ws + WS_SIG);
    const int gw = F.vcu * NWAVES + F.wave, NGW = F.G * NWAVES, lane = F.lane;
    for (int m = gw; m < M; m += NGW) {
        const GAS f32x4* tr = (const GAS f32x4*)(T + (size_t)m * DM) + lane;
        const GAS f32x4* br = (const GAS f32x4*)((MODE == 0 ? x : (const float*)out) + (size_t)m * DM) + lane;
        GAS f32x4* orow = (GAS f32x4*)(out + (size_t)m * DM) + lane;
        f32x4 v[4], bs[4]; float ss = 0.f;
#pragma unroll
        for (int j = 0; j < 4; ++j) { v[j] = tr[64 * j]; bs[j] = br[64 * j];
            if (MODE == 2) { const v2u s = *((const GAS v2u*)(SIG + (size_t)m * DM) + lane + 64 * j); v[j].x *= bflo(s.x); v[j].y *= bfhi(s.x); v[j].z *= bflo(s.y); v[j].w *= bfhi(s.y); }
            ss += (v[j].x * v[j].x + v[j].y * v[j].y) + (v[j].z * v[j].z + v[j].w * v[j].w); }
        const float rstd = 1.0f / sqrtf(wave_sum(ss) * (1.f / DM) + EPS);
        float s2 = 0.f;
#pragma unroll
        for (int j = 0; j < 4; ++j) { const f32x4 g = *((const GAS f32x4*)ga + lane + 64 * j);
            v[j] = bs[j] + v[j] * rstd * g; orow[64 * j] = v[j];
            s2 += (v[j].x * v[j].x + v[j].y * v[j].y) + (v[j].z * v[j].z + v[j].w * v[j].w); }
        if (MODE == 0) {
            const float r2 = 1.0f / sqrtf(wave_sum(s2) * (1.f / DM) + EPS);
            GAS unsigned long long* o8 = (GAS unsigned long long*)(XN + (size_t)m * DM) + lane;
#pragma unroll
            for (int j = 0; j < 4; ++j) { const f32x4 g = *((const GAS f32x4*)gb + lane + 64 * j); const f32x4 u = v[j] * r2 * g;
                o8[64 * j] = (unsigned long long)pk2(u.x, u.y) | ((unsigned long long)pk2(u.z, u.w) << 32); }
        } else if (MODE == 1) {
            GAS unsigned long long* o8 = (GAS unsigned long long*)(XN + (size_t)m * DM) + lane;
#pragma unroll
            for (int j = 0; j < 4; ++j) o8[64 * j] = (unsigned long long)pk2(v[j].x, v[j].y) | ((unsigned long long)pk2(v[j].z, v[j].w) << 32);
        }
    }
}
template <int ACT, bool OUTBF> __device__ __forceinline__ void p_check_gemm(Frame& F, const bf16* Amat, const bf16* Bt, int K, int N, const void* C, int id) {
    const long gt = (long)F.vcu * (NWAVES * 64) + F.tid;
    unsigned hsh = (unsigned)gt * 2654435761u + 12345u * (unsigned)(id + 1);
    for (int s = 0; s < 16; ++s) {
        hsh = hsh * 1664525u + 1013904223u; const int row = (int)((hsh >> 8) % (unsigned)M);
        hsh = hsh * 1664525u + 1013904223u; const int col = (int)((hsh >> 8) % (unsigned)N);
        float acc = 0.f;
        for (int k = 0; k < K; ++k) acc += bf2f(Amat[(size_t)row * K + k]) * bf2f(Bt[(size_t)col * K + k]);
        acc = pg8::act_apply(ACT, acc);
        const float got = OUTBF ? bf2f(((const bf16*)C)[(size_t)row * N + col]) : ((const float*)C)[(size_t)row * N + col];
        const float err = fabsf(got - acc);
        if (!(err <= 0.02f * fabsf(acc) + 0.02f)) atomicAdd((unsigned*)(F.ctl + 64 + id), 1u);
    }
}

constexpr int N_PHASES = 15;
__global__ void __launch_bounds__(NWAVES * 64, 2) mk_fwd(Args args) {
    extern __shared__ __attribute__((aligned(16))) unsigned char lds[];
    Frame F;
    F.lds = (LAS unsigned char*)lds;
    F.MISC = (volatile LAS unsigned*)(F.lds + MISC_OFF);
    F.tid = threadIdx.x; F.lane = F.tid & 63; F.wave = __builtin_amdgcn_readfirstlane(F.tid >> 6);
    F.G = gridDim.x; { const int bx = blockIdx.x; F.vcu = (F.G % 8 == 0) ? (bx % 8) * (F.G / 8) + bx / 8 : bx; }
    unsigned char* ws = args.ws;
    F.ctl = (gu32*)(ws + WS_CTL);
    for (int u = F.tid; u < (LDS_BYTES - LDSCTL_OFF) / 4; u += NWAVES * 64) ((LAS unsigned*)(F.lds + LDSCTL_OFF))[u] = 0u;
    __syncthreads();
    const int lo = args.ph_lo, hi = args.ph_hi;
    const bool multi = (hi - lo) > 1;
    XcdBarrier bar; bar.bar = (unsigned*)(F.ctl + CW_BAR); bar.x = 0; bar.st = nullptr;
    if (multi) bar = xcd_barrier_post((unsigned*)(F.ctl + CW_BAR), F.MISC + 8);
#define IN(k) (lo <= (k) && (k) < hi)
#define SEAM(k) do { if (IN(k) && IN((k) + 1)) xcd_barrier(bar); } while (0)

    if (IN(0)) { p0_prologue(F, args); } SEAM(0);
    if (IN(1)) { pg8::Gemm g{(const bf16*)(ws + WS_XN), (const bf16*)(ws + WS_WIN), M, NPROJ, DM}; pg8::StaticOrder S; S.init(M, NPROJ, F.G, (int)blockIdx.x);
        pg8::EpiBf16<0> E{(bf16*)(ws + WS_PROJ), NPROJ};
        pg8::gemm_phase<pg8::EpiBf16<0>, pg8::StaticOrder, true, true>(F.lds + RING_OFF, g, S, E); } SEAM(1);
    if (IN(2)) { p_split(F, args); } SEAM(2);
    if (IN(3)) { p_conv_naive(F, args); } SEAM(3);
    if (IN(4)) { p_attn_naive(F, args); } SEAM(4);
    if (IN(5)) { p_ssd_naive(F, args); } SEAM(5);
    if (IN(6)) { p_gate_naive(F, args); } SEAM(6);
    if (IN(7)) { pg8::Gemm g{(const bf16*)(ws + WS_MIX), (const bf16*)(ws + WS_WOUT), M, DM, DM}; pg8::StaticOrder S; S.init(M, DM, F.G, (int)blockIdx.x);
        pg8::EpiF32 E{(float*)(ws + WS_T), DM};
        pg8::gemm_phase<pg8::EpiF32, pg8::StaticOrder, true, true>(F.lds + RING_OFF, g, S, E); } SEAM(7);
    if (IN(8)) { p_rows<0>(F, args, (const float*)args.in[4], (const float*)args.in[13]); } SEAM(8);
    if (IN(9)) { pg8::Gemm g{(const bf16*)(ws + WS_XN), (const bf16*)(ws + WS_WUP), M, FF, DM}; pg8::StaticOrder S; S.init(M, FF, F.G, (int)blockIdx.x);
        pg8::EpiBf16<2> E{(bf16*)(ws + WS_H), FF};
        pg8::gemm_phase<pg8::EpiBf16<2>, pg8::StaticOrder, true, true>(F.lds + RING_OFF, g, S, E); } SEAM(9);
    if (IN(10)) { pg8::Gemm g{(const bf16*)(ws + WS_H), (const bf16*)(ws + WS_WDN), M, DM, FF}; pg8::StaticOrder S; S.init(M, DM, F.G, (int)blockIdx.x);
        pg8::EpiF32 E{(float*)(ws + WS_T), DM};
        pg8::gemm_phase<pg8::EpiF32, pg8::StaticOrder, true, true>(F.lds + RING_OFF, g, S, E); } SEAM(10);
    if (IN(11)) { p_rows<1>(F, args, (const float*)args.in[14], nullptr); } SEAM(11);
    if (IN(12)) { pg8::Gemm g{(const bf16*)(ws + WS_XN), (const bf16*)(ws + WS_WG), M, DM, DM}; pg8::StaticOrder S; S.init(M, DM, F.G, (int)blockIdx.x);
        pg8::EpiBf16<3> E{(bf16*)(ws + WS_SIG), DM};
        pg8::gemm_phase<pg8::EpiBf16<3>, pg8::StaticOrder, true, true>(F.lds + RING_OFF, g, S, E); } SEAM(12);
    if (IN(13)) { pg8::Gemm g{(const bf16*)(ws + WS_PB), (const bf16*)(ws + WS_WP), M, DM, PLE}; pg8::StaticOrder S; S.init(M, DM, F.G, (int)blockIdx.x);
        pg8::EpiF32 E{(float*)(ws + WS_T), DM};
        pg8::gemm_phase<pg8::EpiF32, pg8::StaticOrder, true, true>(F.lds + RING_OFF, g, S, E); } SEAM(13);
    if (IN(14)) { p_rows<2>(F, args, (const float*)args.in[19], nullptr); }
#undef IN
#undef SEAM
}

extern "C" void kernel_launch(void* const* d_in, const int* in_sizes, int n_in, void* d_out, int out_size, void* d_ws, size_t ws_size, hipStream_t stream) {
    static int grid = 0;
    if (grid == 0) {
        if (n_in != 20 || in_sizes[0] != M * DM || out_size != M * DM || ws_size < WS_END) {
            fprintf(stderr, "kernel_launch: unexpected shapes: n_in %d in0 %d out %d ws %zu; nothing launched\n", n_in, n_in > 0 ? in_sizes[0] : -1, out_size, ws_size); grid = -1; return; }
        int dev = 0, cus = 0, per_cu = 0;
        if (hipGetDevice(&dev) != hipSuccess || hipDeviceGetAttribute(&cus, hipDeviceAttributeMultiprocessorCount, dev) != hipSuccess) { grid = -1; return; }
        if (hipFuncSetAttribute((const void*)mk_fwd, hipFuncAttributeMaxDynamicSharedMemorySize, LDS_BYTES) != hipSuccess) { fprintf(stderr, "kernel_launch: hipFuncSetAttribute failed\n"); grid = -1; return; }
        if (hipOccupancyMaxActiveBlocksPerMultiprocessor(&per_cu, (const void*)mk_fwd, NWAVES * 64, LDS_BYTES) != hipSuccess || per_cu < 1) {
            fprintf(stderr, "kernel_launch: occupancy query reports %d blocks per CU\n", per_cu); }
        (void)hipGetLastError();
        grid = cus;
    }
    if (grid < 0) return;
    (void)hipMemsetAsync((char*)d_ws + WS_CTL, 0, CTL_ZERO_BYTES, stream);
    Args a{};
    for (int i = 0; i < 20; ++i) a.in[i] = d_in[i];
    a.out = (float*)d_out; a.ws = (unsigned char*)d_ws;
    for (int i = 0; i < 32; ++i) a.inv_freq[i] = (float)pow(10000.0, -(double)i / 32.0);
#if 0
    for (int ph = 0; ph < N_PHASES; ++ph) { a.ph_lo = ph; a.ph_hi = ph + 1; hipLaunchKernelGGL(mk_fwd, dim3(grid), dim3(NWAVES * 64), LDS_BYTES, stream, a); }
#else
    a.ph_lo = 0; a.ph_hi = N_PHASES; hipLaunchKernelGGL(mk_fwd, dim3(grid), dim3(NWAVES * 64), LDS_BYTES, stream, a);
#endif
}
```

```cpp
#include <hip/hip_bf16.h>
#include <cmath>
#include <hip/hip_runtime.h>
#include <cstdio>
#include <cstdint>
namespace pg8 {
#define PG8_LAS __attribute__((address_space(3)))
typedef unsigned short bf16_t;
typedef short bf16x8 __attribute__((ext_vector_type(8)));
typedef float f32x4 __attribute__((ext_vector_type(4)));
typedef unsigned u32x4 __attribute__((ext_vector_type(4)));
constexpr int BM = 256, BK = 64, HALF = 128, HTB = HALF * BK * 2  , STAGE_BYTES = 8 * HTB, NXCD = 8, WGM = 8;

__host__ __device__ __forceinline__ int lds_byte(int r, int c) { const int st = (r >> 4) * 2 + (c >> 5), rr = r & 15, cc = c & 31, ob = rr * 64 + cc * 2; return st * 1024 + (ob ^ (((ob >> 9) & 1) << 5)); }
__host__ __device__ __forceinline__ void stage_rc(int b, int& R, int& C) { const int st = b / 1024, sb = b % 1024, swz = sb ^ (((sb >> 9) & 1) << 5); R = (st >> 1) * 16 + swz / 64; C = (st & 1) * 32 + (swz % 64) / 2; }
__host__ __device__ __forceinline__ int perm32(int rho) { const int n = rho >> 4, i = rho & 15; return 8 * (i >> 2) + 4 * n + (i & 3); }

struct Unit { int pm, pn; };
struct Gemm { const bf16_t* A; const bf16_t* Bt; int M, N, K; };

struct StaticOrder {
    int nM, nN, nwg, G, c;
    __host__ __device__ void init(int M, int N, int G_, int c_) { nM = M / BM; nN = N / BM; nwg = nM * nN; G = G_; c = c_; }
    __host__ __device__ bool next(int i, Unit& u) const {
        const long L = (long)i * G + c; if (L >= nwg) return false;
        int wgid = (int)L; { const int q = nwg / NXCD, r = nwg % NXCD, xcd = wgid % NXCD, off = wgid / NXCD; wgid = (xcd < r ? xcd * (q + 1) : r * (q + 1) + (xcd - r) * q) + off; }
        const int nig = WGM * nN, gid = wgid / nig, fm = gid * WGM, gsz = (nM - fm) < WGM ? (nM - fm) : WGM;
        u.pm = fm + ((wgid % nig) % gsz); u.pn = (wgid % nig) / gsz; return true;
    }
    __device__ __forceinline__ void a_ready(const Unit&) const {}
    __device__ __forceinline__ void done(const Unit&) const {}
};


typedef float f32x2 __attribute__((ext_vector_type(2))); typedef __bf16 bf16x2_t __attribute__((ext_vector_type(2)));
__device__ __forceinline__ unsigned cvt_pk_bf16(float lo, float hi) { const f32x2 v = {lo, hi}; const bf16x2_t b = __builtin_convertvector(v, bf16x2_t); return __builtin_bit_cast(unsigned, b); }

__device__ __forceinline__ float act_apply(int ACT, float v) {
    if (ACT == 2) { const float r = v > 0.f ? v : 0.f; return r * r; }
    if (ACT == 3) { return __builtin_amdgcn_rcpf(1.0f + __builtin_amdgcn_exp2f(-1.4426950408889634f * v)); }
    return v;
}
template <int ACT> struct EpiBf16 {
    static constexpr bool PERM = true, AFTER_DRAIN = false;
    bf16_t* O; int ldc;
    __device__ __forceinline__ void operator()(const f32x4 (&acc)[2][2][4][2], const Unit& u, int wr, int wc, int fr, int fq) const {
        const int row0 = u.pm * BM + wr * 64 + fr; const int col0 = u.pn * BM + wc * 32 + 8 * fq;
#pragma unroll
        for (int ai = 0; ai < 2; ++ai)
#pragma unroll
            for (int m = 0; m < 4; ++m) { bf16_t* rowp = O + (size_t)(row0 + ai * HALF + m * 16) * ldc + col0;
#pragma unroll
                for (int bj = 0; bj < 2; ++bj) { f32x4 v0 = acc[ai][bj][m][0], v1 = acc[ai][bj][m][1];
#pragma unroll
                    for (int e = 0; e < 4; ++e) { v0[e] = act_apply(ACT, v0[e]); v1[e] = act_apply(ACT, v1[e]); }
                    u32x4 w; w.x = cvt_pk_bf16(v0[0], v0[1]); w.y = cvt_pk_bf16(v0[2], v0[3]); w.z = cvt_pk_bf16(v1[0], v1[1]); w.w = cvt_pk_bf16(v1[2], v1[3]);
                    *(u32x4*)(rowp + bj * HALF) = w; } }
    }
};
struct EpiF32 {
    static constexpr bool PERM = false, AFTER_DRAIN = false;
    float* O; int ldc;
    __device__ __forceinline__ void operator()(const f32x4 (&acc)[2][2][4][2], const Unit& u, int wr, int wc, int fr, int fq) const {
        const int row0 = u.pm * BM + wr * 64 + fr; const int col0 = u.pn * BM + wc * 32 + 4 * fq;
#pragma unroll
        for (int ai = 0; ai < 2; ++ai)
#pragma unroll
            for (int m = 0; m < 4; ++m) { float* rowp = O + (size_t)(row0 + ai * HALF + m * 16) * ldc + col0;
#pragma unroll
                for (int bj = 0; bj < 2; ++bj)
#pragma unroll
                    for (int n = 0; n < 2; ++n) *(f32x4*)(rowp + bj * HALF + n * 16) = acc[ai][bj][m][n]; }
    }
};
template <class Epi, class Sched, bool ALIGN_EPI = false, bool SP2 = false>
__device__ __forceinline__ void gemm_phase(PG8_LAS unsigned char* lds, const Gemm g, const Sched& S, const Epi& E) {
    const int tid = threadIdx.x, wid = __builtin_amdgcn_readfirstlane(tid >> 6), lane = tid & 63, wr = wid >> 2, wc = wid & 3, fr = lane & 15, fq = lane >> 4;
    const int K = g.K, nt = K / BK;
    unsigned voffA[2], voffB[2];
#pragma unroll
    for (int i = 0; i < 2; ++i) { int R, C; stage_rc(tid * 16 + i * 8192, R, C); const int Rb = Epi::PERM ? ((R & ~31) + perm32(R & 31)) : R;
        voffA[i] = (unsigned)(R * K + C) * 2u; voffB[i] = (unsigned)(Rb * K + C) * 2u; }
    const size_t kstep = (size_t)(BK * 2);
    const size_t hstep = (size_t)HALF * K * 2;
    const size_t tstep = 2 * hstep;
    const unsigned ldsw = (unsigned)wid * 1024u;
    const int aoff = lds_byte(wr * 64 + fr, fq * 8), boff = lds_byte(wc * 32 + fr, fq * 8);
#define PG8_SA(b, h) (((b) * 2 + (h)) * HTB)
#define PG8_SB(b, h) ((4 + (b) * 2 + (h)) * HTB)
#define PG8_STAGE(bufoff, gbase, voff) do { _Pragma("unroll") for (int _i = 0; _i < 2; ++_i) \
        __builtin_amdgcn_global_load_lds((const unsigned*)((const char*)(gbase) + (voff)[_i]), (PG8_LAS unsigned*)(lds + (bufoff) + ldsw + _i * 8192), 16, 0, 0); } while (0)
#define PG8_LDA(dst, b, h) do { _Pragma("unroll") for (int m = 0; m < 4; ++m) _Pragma("unroll") for (int k = 0; k < 2; ++k) dst[m][k] = *(const PG8_LAS bf16x8*)(lds + PG8_SA(b, h) + aoff + m * 2048 + k * 1024); } while (0)
#define PG8_LDB(dst, b, h) do { _Pragma("unroll") for (int n = 0; n < 2; ++n) _Pragma("unroll") for (int k = 0; k < 2; ++k) dst[n][k] = *(const PG8_LAS bf16x8*)(lds + PG8_SB(b, h) + boff + n * 2048 + k * 1024); } while (0)
#define PG8_MMA(ai, bj, At, Bt) do { __builtin_amdgcn_s_setprio(1); _Pragma("unroll") for (int m = 0; m < 4; ++m) _Pragma("unroll") for (int n = 0; n < 2; ++n) _Pragma("unroll") for (int k = 0; k < 2; ++k) \
        acc[ai][bj][m][n] = __builtin_amdgcn_mfma_f32_16x16x32_bf16(Bt[n][k], At[m][k], acc[ai][bj][m][n], 0, 0, 0); __builtin_amdgcn_s_setprio(0); } while (0)
#define PG8_WAIT_V(n) asm volatile("s_waitcnt vmcnt(" #n ")" ::: "memory")
#define PG8_WAIT_L(n) asm volatile("s_waitcnt lgkmcnt(" #n ")" ::: "memory")
#define PG8_BAR __builtin_amdgcn_s_barrier()
#define PG8_SCHED __builtin_amdgcn_sched_barrier(0)
    Unit cur, nxt; int ui = 0;
    if (!S.next(0, cur)) return;
    f32x4 acc[2][2][4][2];
#pragma unroll
    for (int a = 0; a < 2; ++a)
#pragma unroll
        for (int b = 0; b < 2; ++b)
#pragma unroll
            for (int m = 0; m < 4; ++m)
#pragma unroll
                for (int n = 0; n < 2; ++n) acc[a][b][m][n] = (f32x4){0.f, 0.f, 0.f, 0.f};
    bf16x8 At[4][2], B0[2][2], B1[2][2];
    const char* cA = (const char*)g.A + (size_t)cur.pm * tstep; const char* cB = (const char*)g.Bt + (size_t)cur.pn * tstep;
    S.a_ready(cur);
    if constexpr (SP2) {
        PG8_STAGE(PG8_SB(0, 0), cB, voffB); PG8_STAGE(PG8_SB(0, 1), cB + hstep, voffB); PG8_STAGE(PG8_SA(0, 0), cA, voffA); PG8_STAGE(PG8_SA(0, 1), cA + hstep, voffA);
        if (wr == 1) PG8_BAR;
        PG8_WAIT_V(2); PG8_BAR;
        PG8_STAGE(PG8_SB(1, 0), cB + kstep, voffB); PG8_STAGE(PG8_SA(1, 0), cA + kstep, voffA); PG8_STAGE(PG8_SB(1, 1), cB + hstep + kstep, voffB);
        PG8_WAIT_V(6); PG8_BAR;
    } else {
        PG8_STAGE(PG8_SB(0, 0), cB, voffB); PG8_STAGE(PG8_SA(0, 0), cA, voffA); PG8_STAGE(PG8_SB(0, 1), cB + hstep, voffB); PG8_STAGE(PG8_SA(0, 1), cA + hstep, voffA);
        if (wr == 1) PG8_BAR;
        PG8_WAIT_V(4); PG8_BAR;
        PG8_STAGE(PG8_SB(1, 0), cB + kstep, voffB); PG8_STAGE(PG8_SA(1, 0), cA + kstep, voffA); PG8_STAGE(PG8_SB(1, 1), cB + hstep + kstep, voffB);
        PG8_WAIT_V(6); PG8_BAR;
    }
    for (;;) {
        const bool has_next = S.next(ui + 1, nxt);
        const char* nA = has_next ? (const char*)g.A + (size_t)nxt.pm * tstep : cA; const char* nB = has_next ? (const char*)g.Bt + (size_t)nxt.pn * tstep : cB;
        for (int t = 0; t < nt; t += 2) {
            const bool last = (t == nt - 2);
            const char* a1 = cA + (size_t)(t + 1) * kstep;
            const char* a2 = last ? nA : cA + (size_t)(t + 2) * kstep; const char* b2 = last ? nB : cB + (size_t)(t + 2) * kstep;
            const char* a3 = a2 + kstep; const char* b3 = b2 + kstep;
            if (last && has_next) S.a_ready(nxt);
            if constexpr (SP2) {
            PG8_LDB(B0, 0, 0); PG8_LDB(B1, 0, 1); PG8_SCHED; PG8_LDA(At, 0, 0); PG8_STAGE(PG8_SA(1, 1), a1 + hstep, voffA);
            PG8_WAIT_V(8); PG8_WAIT_L(0); PG8_BAR; PG8_MMA(0, 0, At, B0); PG8_MMA(0, 1, At, B1); PG8_BAR; PG8_SCHED;
            PG8_LDA(At, 0, 1); PG8_STAGE(PG8_SB(0, 0), b2, voffB); PG8_STAGE(PG8_SB(0, 1), b2 + hstep, voffB); PG8_STAGE(PG8_SA(0, 0), a2, voffA);
            PG8_WAIT_V(8); PG8_WAIT_L(0); PG8_BAR; PG8_MMA(1, 0, At, B0); PG8_MMA(1, 1, At, B1); PG8_BAR; PG8_SCHED;
            PG8_LDB(B0, 1, 0); PG8_LDB(B1, 1, 1); PG8_SCHED; PG8_LDA(At, 1, 0); PG8_STAGE(PG8_SA(0, 1), a2 + hstep, voffA);
            PG8_WAIT_V(8); PG8_WAIT_L(0); PG8_BAR; PG8_MMA(0, 0, At, B0); PG8_MMA(0, 1, At, B1); PG8_BAR; PG8_SCHED;
            PG8_LDA(At, 1, 1); PG8_STAGE(PG8_SB(1, 0), b3, voffB); PG8_STAGE(PG8_SB(1, 1), b3 + hstep, voffB); PG8_STAGE(PG8_SA(1, 0), a3, voffA);
            PG8_WAIT_V(8); PG8_WAIT_L(0); PG8_BAR; PG8_MMA(1, 0, At, B0); PG8_MMA(1, 1, At, B1); PG8_BAR; PG8_SCHED;
            } else {
            PG8_LDB(B0, 0, 0); PG8_SCHED; PG8_LDA(At, 0, 0); PG8_STAGE(PG8_SA(1, 1), a1 + hstep, voffA);
            PG8_WAIT_L(8); PG8_BAR; PG8_WAIT_L(0); PG8_MMA(0, 0, At, B0); PG8_BAR; PG8_SCHED;
            PG8_LDB(B1, 0, 1); PG8_STAGE(PG8_SB(0, 0), b2, voffB);
            PG8_BAR; PG8_WAIT_L(0); PG8_MMA(0, 1, At, B1); PG8_BAR;
            PG8_LDA(At, 0, 1); PG8_STAGE(PG8_SA(0, 0), a2, voffA);
            PG8_BAR; PG8_WAIT_L(0); PG8_MMA(1, 0, At, B0); PG8_BAR; PG8_SCHED;
            PG8_STAGE(PG8_SB(0, 1), b2 + hstep, voffB);
            PG8_WAIT_V(6); PG8_BAR; PG8_MMA(1, 1, At, B1); PG8_BAR;
            PG8_LDB(B0, 1, 0); PG8_SCHED; PG8_LDA(At, 1, 0); PG8_STAGE(PG8_SA(0, 1), a2 + hstep, voffA);
            PG8_WAIT_L(8); PG8_BAR; PG8_WAIT_L(0); PG8_MMA(0, 0, At, B0); PG8_BAR; PG8_SCHED;
            PG8_LDB(B1, 1, 1); PG8_STAGE(PG8_SB(1, 0), b3, voffB);
            PG8_BAR; PG8_WAIT_L(0); PG8_MMA(0, 1, At, B1); PG8_BAR;
            PG8_LDA(At, 1, 1); PG8_STAGE(PG8_SA(1, 0), a3, voffA);
            PG8_BAR; PG8_WAIT_L(0); PG8_MMA(1, 0, At, B0); PG8_BAR; PG8_SCHED;
            PG8_STAGE(PG8_SB(1, 1), b3 + hstep, voffB);
            PG8_WAIT_V(6); PG8_BAR; PG8_MMA(1, 1, At, B1); PG8_BAR;
            }
        }
        if constexpr (ALIGN_EPI) { if (wr == 0) PG8_BAR; }
        if constexpr (!Epi::AFTER_DRAIN) { E(acc, cur, wr, wc, fr, fq); S.done(cur); }
        if (!has_next) break;
#pragma unroll
        for (int a = 0; a < 2; ++a)
#pragma unroll
            for (int b = 0; b < 2; ++b)
#pragma unroll
                for (int m = 0; m < 4; ++m)
#pragma unroll
                    for (int n = 0; n < 2; ++n) acc[a][b][m][n] = (f32x4){0.f, 0.f, 0.f, 0.f};
        cur = nxt; cA = nA; cB = nB; ++ui;
        if constexpr (ALIGN_EPI) { if (wr == 1) PG8_BAR; }
    }
    PG8_WAIT_V(0);
    if constexpr (!ALIGN_EPI) { if (wr == 0) PG8_BAR; }
    PG8_BAR;
    if constexpr (Epi::AFTER_DRAIN) { E.fused(acc, cur, wr, wc, fr, fq, lds, wid, lane); S.done(cur); }
#undef PG8_SA
#undef PG8_SB
#undef PG8_STAGE
#undef PG8_LDA
#undef PG8_LDB
#undef PG8_MMA
#undef PG8_WAIT_V
#undef PG8_WAIT_L
#undef PG8_BAR
#undef PG8_SCHED
}
}
#define GAS __attribute__((address_space(1)))
#define LAS __attribute__((address_space(3)))
typedef unsigned short bf16;
typedef float f32x2v __attribute__((ext_vector_type(2)));
typedef unsigned v4u __attribute__((ext_vector_type(4)));
typedef float f32x4 __attribute__((ext_vector_type(4)));
typedef short bf16x8 __attribute__((ext_vector_type(8)));
typedef GAS unsigned gu32;
typedef GAS unsigned long long gu64;
#define RLX_AGENT __ATOMIC_RELAXED, __HIP_MEMORY_SCOPE_AGENT
#define LDS_WAIT() asm volatile("s_waitcnt lgkmcnt(0)" ::: "memory")
#define VM_WAIT() asm volatile("s_waitcnt vmcnt(0)" ::: "memory")
__device__ __forceinline__ unsigned long long rt() { return __builtin_amdgcn_s_memrealtime(); }
__device__ __forceinline__ unsigned f2bf(float f) { unsigned u = __builtin_bit_cast(unsigned, f); return (u + 0x7fffu + ((u >> 16) & 1u)) >> 16; }
__device__ __forceinline__ unsigned pk2(float lo, float hi) { return f2bf(lo) | (f2bf(hi) << 16); }

#define XB_TMO      128
#define XB_XCNT(j)  (256  + 64 * (j))
#define XB_XSUB(j)  (1280 + 64 * (j))
#define XB_XGEN(j)  (2304 + 64 * (j))
#define XB_TOP      3328
#define XB_TOPGEN   3392
#define XCD_BAR_WORDS 3456
#define XB_SPIN_CAP (1u << 18)

__device__ __forceinline__ unsigned xb_ld(unsigned* p)              { return __hip_atomic_load(p, __ATOMIC_RELAXED, __HIP_MEMORY_SCOPE_AGENT); }
__device__ __forceinline__ unsigned xb_add(unsigned* p, unsigned v) { return __hip_atomic_fetch_add(p, v, __ATOMIC_RELAXED, __HIP_MEMORY_SCOPE_AGENT); }
__device__ __forceinline__ unsigned xb_xcc_id() { return (unsigned)__builtin_amdgcn_s_getreg((3 << 11) | 20) & 0xFu; }
#define XB_SPIN(cond, bar) do { unsigned _sp = 0; while (cond) { __builtin_amdgcn_s_sleep(1); \
    if ((++_sp & 255u) == 0u) { if (xb_ld(&(bar)[XB_TMO])) break; if (_sp > XB_SPIN_CAP) { atomicAdd(&(bar)[XB_TMO], 1u); break; } } } } while (0)

struct XcdBarrier {
    unsigned* bar; unsigned x;
    volatile LAS unsigned* st;
};

__device__ __forceinline__ XcdBarrier xcd_barrier_post(unsigned* bar, volatile LAS unsigned* st) {
    XcdBarrier b; b.bar = bar; b.x = xb_xcc_id(); b.st = st;
    if (threadIdx.x == 0) (void)xb_add(&bar[XB_XCNT(b.x)], 1u);
    return b;
}
__device__ __forceinline__ void xcd_barrier_complete(unsigned* bar, unsigned x, unsigned& nloc, unsigned& nx) {
    const unsigned G = gridDim.x * gridDim.y * gridDim.z;
    unsigned sum, cnt, mine, sp = 0u;
    for (;;) {
        sum = 0u; cnt = 0u; mine = 0u;
#pragma unroll
        for (unsigned j = 0; j < 16; ++j) { const unsigned c = xb_ld(&bar[XB_XCNT(j)]); sum += c; cnt += (c > 0u) ? 1u : 0u; mine = (j == x) ? c : mine; }
        if (sum == G) break;
        __builtin_amdgcn_s_sleep(1);
        if ((++sp & 255u) == 0u) { if (xb_ld(&bar[XB_TMO])) break; if (sp > XB_SPIN_CAP) { atomicAdd(&bar[XB_TMO], 1u); break; } }
    }
    nloc = mine > 0u ? mine : 1u; nx = cnt > 0u ? cnt : 1u;
}

__device__ __forceinline__ void xcd_barrier(const XcdBarrier& b) {
    asm volatile("s_waitcnt vmcnt(0)" ::: "memory");
    __syncthreads();
    if (threadIdx.x == 0) {
        unsigned* bar = b.bar;
        __builtin_amdgcn_s_waitcnt(0);
        unsigned nloc = b.st[0], nx = b.st[1];
        if (nloc == 0u) { xcd_barrier_complete(bar, b.x, nloc, nx); b.st[0] = nloc; b.st[1] = nx; }
        const unsigned old = xb_add(&bar[XB_XSUB(b.x)], 1u);
        const unsigned gen = old / nloc;
        if (old + 1u == (gen + 1u) * nloc) {
            __builtin_amdgcn_fence(__ATOMIC_RELEASE, "agent");
            asm volatile("s_waitcnt vmcnt(0)" ::: "memory");
            const unsigned og = xb_add(&bar[XB_TOP], 1u);
            const unsigned tg = og / nx;
            if (og + 1u == (tg + 1u) * nx) xb_add(&bar[XB_TOPGEN], 1u);
            else XB_SPIN(xb_ld(&bar[XB_TOPGEN]) == tg, bar);
            __builtin_amdgcn_fence(__ATOMIC_ACQUIRE, "agent");
            xb_add(&bar[XB_XGEN(b.x)], 1u);
            asm volatile("s_waitcnt vmcnt(0)" ::: "memory");
        } else {
            XB_SPIN(xb_ld(&bar[XB_XGEN(b.x)]) == gen, bar);
            __builtin_amdgcn_fence(__ATOMIC_ACQUIRE, "agent");
            asm volatile("s_waitcnt vmcnt(0)" ::: "memory");
        }
    }
    __syncthreads();
}

constexpr int NWAVES = 8;
constexpr int BATCH = 8, SEQ = 4096, DM = 1024, M = BATCH * SEQ;
constexpr int NPROJ = 2816, NPROJ_SRC = 2824;
constexpr int FF = 4096, PLE = 256, NH = 8, HD = 64, SSD_N = 128, CONVC = 768, CHUNK = 128, NCHUNK = SEQ / CHUNK;
constexpr float EPS = 1e-6f;
constexpr float QSCALE = 0.125f * 1.4426950408889634f;

constexpr size_t MiB = 1u << 20;
constexpr size_t WS_CTL = 0, CTL_ZERO_BYTES = 1 * MiB;
constexpr size_t WS_DT = 1 * MiB;
constexpr size_t WS_TAB = 8 * MiB;
constexpr size_t WS_WIN = 16 * MiB, WS_WOUT = 22 * MiB, WS_WUP = 24 * MiB, WS_WDN = 32 * MiB, WS_WG = 40 * MiB, WS_WP = 42 * MiB;
constexpr size_t WS_XN = 48 * MiB;
constexpr size_t WS_PB = 112 * MiB;
constexpr size_t WS_H = 128 * MiB;
constexpr size_t WS_QKV = 128 * MiB;
constexpr size_t WS_Z = 224 * MiB;
constexpr size_t WS_XBC = 256 * MiB;
constexpr size_t WS_MIX = 256 * MiB;
constexpr size_t WS_PROJ = 320 * MiB;
constexpr size_t WS_XC = 384 * MiB;
constexpr size_t WS_Y = 384 * MiB;
constexpr size_t WS_CHD = 2 * MiB;
constexpr size_t WS_XT = 320 * MiB;
constexpr size_t WS_BN = 352 * MiB;
constexpr size_t WS_BT = 360 * MiB;
constexpr size_t WS_CN = 368 * MiB;
constexpr size_t WS_ST = 128 * MiB;
constexpr size_t WS_PREV = 160 * MiB;
constexpr size_t WS_T = 384 * MiB;
constexpr size_t WS_SIG = 128 * MiB;
constexpr size_t WS_END = 512 * MiB;
constexpr int CW_TMO = 0, CW_CODE = 1, CW_BAR = 4096;

constexpr int RING_OFF = 0, RING_BYTES = 131072;
constexpr int LDSCTL_OFF = RING_BYTES, MISC_OFF = LDSCTL_OFF + 320;
constexpr int LDS_BYTES = 163840;

struct Args { const void* in[20]; float* out; unsigned char* ws; float inv_freq[32]; };
struct Frame {
    LAS unsigned char* lds;
    volatile LAS unsigned* MISC;
    gu32* ctl;
    int tid, lane, wave, vcu, G;
};
typedef unsigned v2u __attribute__((ext_vector_type(2)));
__device__ __forceinline__ float bf2f(unsigned short b) { return __builtin_bit_cast(float, (unsigned)b << 16); }
__device__ __forceinline__ float bflo(unsigned w) { return __builtin_bit_cast(float, w << 16); }
__device__ __forceinline__ float bfhi(unsigned w) { return __builtin_bit_cast(float, w & 0xffff0000u); }
__device__ __forceinline__ float wave_sum(float v) {
#pragma unroll
    for (int o = 1; o < 64; o <<= 1) v += __shfl_xor(v, o);
    return v;
}
__device__ __forceinline__ float silu_f(float v) { return v / (1.0f + __expf(-v)); }

__device__ __forceinline__ void p0_transpose_item(const float* W, int K, int ldw, int ncols, bf16* WT, LAS float* scr, int item, int lane) {
    const int nblk = ncols / 32, kb = item / nblk, nb = item % nblk, k0 = 64 * kb, n0 = 32 * nb;
#pragma unroll 8
    for (int i = 0; i < 32; ++i) { const int kk = 2 * i + (lane >> 5); scr[kk * 33 + (lane & 31)] = W[(size_t)(k0 + kk) * ldw + n0 + (lane & 31)]; }
    LDS_WAIT(); asm volatile("" ::: "memory");
    const int c = lane & 7;
#pragma unroll
    for (int j = 0; j < 4; ++j) { const int n = (lane >> 3) + 8 * j; const LAS float* s = scr + (8 * c) * 33 + n;
        v4u o; o.x = pk2(s[0 * 33], s[1 * 33]); o.y = pk2(s[2 * 33], s[3 * 33]); o.z = pk2(s[4 * 33], s[5 * 33]); o.w = pk2(s[6 * 33], s[7 * 33]);
        *(GAS v4u*)(WT + (size_t)(n0 + n) * K + k0 + 8 * c) = o; }
    LDS_WAIT(); asm volatile("" ::: "memory");
}
__device__ __forceinline__ void p0_prologue(Frame& F, const Args& A) {
    unsigned char* ws = A.ws;
    LAS float* scr = (LAS float*)(F.lds + RING_OFF + F.wave * 16384);
    const int gw = F.vcu * NWAVES + F.wave, NGW = F.G * NWAVES;
    const float* w_in = (const float*)A.in[5]; const float* w_out = (const float*)A.in[12]; const float* w_up = (const float*)A.in[15];
    const float* w_dn = (const float*)A.in[16]; const float* w_g = (const float*)A.in[17]; const float* w_p = (const float*)A.in[18];
    constexpr int I_IN = (DM / 64) * (NPROJ / 32), I_OUT = (DM / 64) * (DM / 32), I_UP = (DM / 64) * (FF / 32), I_DN = (FF / 64) * (DM / 32), I_G = I_OUT, I_P = (PLE / 64) * (DM / 32);
    constexpr int NITEMS = I_IN + I_OUT + I_UP + I_DN + I_G + I_P;
    for (int it = gw; it < NITEMS; it += NGW) {
        int r = it;
        if (r < I_IN) { p0_transpose_item(w_in, DM, NPROJ_SRC, NPROJ, (bf16*)(ws + WS_WIN), scr, r, F.lane); continue; } r -= I_IN;
        if (r < I_OUT) { p0_transpose_item(w_out, DM, DM, DM, (bf16*)(ws + WS_WOUT), scr, r, F.lane); continue; } r -= I_OUT;
        if (r < I_UP) { p0_transpose_item(w_up, DM, FF, FF, (bf16*)(ws + WS_WUP), scr, r, F.lane); continue; } r -= I_UP;
        if (r < I_DN) { p0_transpose_item(w_dn, FF, DM, DM, (bf16*)(ws + WS_WDN), scr, r, F.lane); continue; } r -= I_DN;
        if (r < I_G) { p0_transpose_item(w_g, DM, DM, DM, (bf16*)(ws + WS_WG), scr, r, F.lane); continue; } r -= I_G;
        p0_transpose_item(w_p, PLE, DM, DM, (bf16*)(ws + WS_WP), scr, r, F.lane);
    }
    const float* x = (const float*)A.in[0]; const float* pin = (const float*)A.in[1]; const int* pos = (const int*)A.in[2];
    const float* g_pre = (const float*)A.in[3]; const float* dt_bias = (const float*)A.in[8];
    bf16* XN = (bf16*)(ws + WS_XN); bf16* PB = (bf16*)(ws + WS_PB); float* DT = (float*)(ws + WS_DT); float* TAB = (float*)(ws + WS_TAB);
    const int lane = F.lane;
    const float myfreq = A.inv_freq[lane & 31];
    for (int m = gw; m < M; m += NGW) {
        const GAS f32x4* xr = (const GAS f32x4*)(x + (size_t)m * DM) + lane;
        const GAS f32x4* gr = (const GAS f32x4*)g_pre + lane;
        f32x4 v[4]; float ss = 0.f;
#pragma unroll
        for (int j = 0; j < 4; ++j) { v[j] = xr[64 * j]; ss += (v[j].x * v[j].x + v[j].y * v[j].y) + (v[j].z * v[j].z + v[j].w * v[j].w); }
        const float rstd = 1.0f / sqrtf(wave_sum(ss) * (1.f / DM) + EPS);
        GAS unsigned long long* o8 = (GAS unsigned long long*)(XN + (size_t)m * DM) + lane;
        float dacc[8];
#pragma unroll
        for (int q = 0; q < 8; ++q) dacc[q] = 0.f;
#pragma unroll
        for (int j = 0; j < 4; ++j) {
            const f32x4 g = gr[64 * j]; v[j] = v[j] * rstd * g;
            o8[64 * j] = (unsigned long long)pk2(v[j].x, v[j].y) | ((unsigned long long)pk2(v[j].z, v[j].w) << 32);
#pragma unroll
            for (int e = 0; e < 4; ++e) {
                const int k = 256 * j + 4 * lane + e;
                const GAS f32x4* wp = (const GAS f32x4*)(w_in + (size_t)k * NPROJ_SRC + NPROJ);
                const f32x4 w0 = wp[0], w1 = wp[1]; const float uv = v[j][e];
                dacc[0] += uv * w0.x; dacc[1] += uv * w0.y; dacc[2] += uv * w0.z; dacc[3] += uv * w0.w;
                dacc[4] += uv * w1.x; dacc[5] += uv * w1.y; dacc[6] += uv * w1.z; dacc[7] += uv * w1.w;
            }
        }
#pragma unroll
        for (int q = 0; q < 8; ++q) dacc[q] = wave_sum(dacc[q]);
        if (lane < 8) {
            float d = dacc[0];
#pragma unroll
            for (int q = 1; q < 8; ++q) d = (lane == q) ? dacc[q] : d;
            d += dt_bias[lane];
            const float sp = d > 20.f ? d : log1pf(expf(d));
            DT[(size_t)m * 8 + lane] = sp;
        }
        if (lane < 32) {
            const float ang = (float)pos[m] * myfreq; float sn, cs; sincosf(ang, &sn, &cs);
            *(GAS f32x2v*)(TAB + ((size_t)m * 32 + lane) * 2) = (f32x2v){cs, sn};
        }
        { const f32x4 pv = *((const GAS f32x4*)(pin + (size_t)m * PLE) + lane);
          *((GAS unsigned long long*)(PB + (size_t)m * PLE) + lane) = (unsigned long long)pk2(pv.x, pv.y) | ((unsigned long long)pk2(pv.z, pv.w) << 32); }
    }
}

__device__ __forceinline__ void p_split(Frame& F, const Args& A) {
    unsigned char* ws = A.ws;
    const bf16* PROJ = (const bf16*)(ws + WS_PROJ); bf16* QKV = (bf16*)(ws + WS_QKV); bf16* Z = (bf16*)(ws + WS_Z); bf16* XBC = (bf16*)(ws + WS_XBC);
    const float* TAB = (const float*)(ws + WS_TAB);
    const long gt = (long)F.vcu * (NWAVES * 64) + F.tid, NT = (long)F.G * NWAVES * 64;
    for (long it = gt; it < (long)M * 288; it += NT) {
        const int row = (int)(it / 288), c = (int)(it % 288);
        const bf16* src = PROJ + (size_t)row * NPROJ;
        if (c < 64) {
            const int hd = c >> 2, i0 = 8 * (c & 3); const float sc = hd < 8 ? QSCALE : 1.0f;
            const v4u a = *(const GAS v4u*)(src + hd * 64 + i0), b = *(const GAS v4u*)(src + hd * 64 + 32 + i0);
            const GAS f32x4* tb = (const GAS f32x4*)(TAB + ((size_t)row * 32 + i0) * 2);
            float t1[8], t2[8], o1[8], o2[8];
            t1[0] = bflo(a.x); t1[1] = bfhi(a.x); t1[2] = bflo(a.y); t1[3] = bfhi(a.y); t1[4] = bflo(a.z); t1[5] = bfhi(a.z); t1[6] = bflo(a.w); t1[7] = bfhi(a.w);
            t2[0] = bflo(b.x); t2[1] = bfhi(b.x); t2[2] = bflo(b.y); t2[3] = bfhi(b.y); t2[4] = bflo(b.z); t2[5] = bfhi(b.z); t2[6] = bflo(b.w); t2[7] = bfhi(b.w);
#pragma unroll
            for (int e2 = 0; e2 < 4; ++e2) { const f32x4 cs = tb[e2];
                o1[2 * e2] = (t1[2 * e2] * cs.x - t2[2 * e2] * cs.y) * sc; o2[2 * e2] = (t2[2 * e2] * cs.x + t1[2 * e2] * cs.y) * sc;
                o1[2 * e2 + 1] = (t1[2 * e2 + 1] * cs.z - t2[2 * e2 + 1] * cs.w) * sc; o2[2 * e2 + 1] = (t2[2 * e2 + 1] * cs.z + t1[2 * e2 + 1] * cs.w) * sc; }
            v4u w1, w2; w1.x = pk2(o1[0], o1[1]); w1.y = pk2(o1[2], o1[3]); w1.z = pk2(o1[4], o1[5]); w1.w = pk2(o1[6], o1[7]);
            w2.x = pk2(o2[0], o2[1]); w2.y = pk2(o2[2], o2[3]); w2.z = pk2(o2[4], o2[5]); w2.w = pk2(o2[6], o2[7]);
            bf16* dst = QKV + (size_t)row * 1536 + hd * 64 + i0;
            *(GAS v4u*)dst = w1; *(GAS v4u*)(dst + 32) = w2;
        } else if (c < 128) {
            const int col = 1024 + 8 * (c - 64);
            *(GAS v4u*)(QKV + (size_t)row * 1536 + col) = *(const GAS v4u*)(src + col);
        } else if (c < 192) {
            const int cc = 8 * (c - 128); const v4u a = *(const GAS v4u*)(src + 1536 + cc); v4u w;
            w.x = pk2(silu_f(bflo(a.x)), silu_f(bfhi(a.x))); w.y = pk2(silu_f(bflo(a.y)), silu_f(bfhi(a.y)));
            w.z = pk2(silu_f(bflo(a.z)), silu_f(bfhi(a.z))); w.w = pk2(silu_f(bflo(a.w)), silu_f(bfhi(a.w)));
            *(GAS v4u*)(Z + (size_t)row * 512 + cc) = w;
        } else {
            const int cc = 8 * (c - 192);
            *(GAS v4u*)(XBC + (size_t)row * CONVC + cc) = *(const GAS v4u*)(src + 2048 + cc);
        }
    }
}

__device__ __forceinline__ void p_conv(Frame& F, const Args& A) {
    unsigned char* ws = A.ws;
    const bf16* XBC = (const bf16*)(ws + WS_XBC);
    bf16* XT = (bf16*)(ws + WS_XT); bf16* BN = (bf16*)(ws + WS_BN); bf16* BT = (bf16*)(ws + WS_BT); bf16* CN = (bf16*)(ws + WS_CN);
    const float* cw = (const float*)A.in[6]; const float* cb = (const float*)A.in[7];
    const int gw = F.vcu * NWAVES + F.wave, NGW = F.G * NWAVES, lane = F.lane;
    for (int it = gw; it < BATCH * NCHUNK * 12; it += NGW) {
        const int fg = it % 12, bc = it / 12, col = fg * 64 + lane;
        const size_t row0 = (size_t)bc * CHUNK;
        const float w0 = cw[col], w1 = cw[CONVC + col], w2 = cw[2 * CONVC + col], w3 = cw[3 * CONVC + col], bias = cb[col];
        float xm3 = 0.f, xm2 = 0.f, xm1 = 0.f;
        if ((bc & (NCHUNK - 1)) != 0) { xm3 = bf2f(XBC[(row0 - 3) * CONVC + col]); xm2 = bf2f(XBC[(row0 - 2) * CONVC + col]); xm1 = bf2f(XBC[(row0 - 1) * CONVC + col]); }
        bf16* tdst = fg < 8 ? XT + ((size_t)(bc * 8 + fg) * 64 + lane) * CHUNK : BT + ((size_t)bc * SSD_N + (fg - 8) * 64 + lane) * CHUNK;
        bf16* ndst = fg < 10 ? BN + row0 * SSD_N + (fg - 8) * 64 + lane : CN + row0 * SSD_N + (fg - 10) * 64 + lane;
        for (int t0 = 0; t0 < CHUNK; t0 += 8) {
            float xin[8], o[8];
#pragma unroll
            for (int u = 0; u < 8; ++u) xin[u] = bf2f(XBC[(row0 + t0 + u) * CONVC + col]);
#pragma unroll
            for (int u = 0; u < 8; ++u) { const float a = bias + w0 * xm3 + w1 * xm2 + w2 * xm1 + w3 * xin[u]; o[u] = silu_f(a); xm3 = xm2; xm2 = xm1; xm1 = xin[u]; }
            if (fg < 10) { v4u w; w.x = pk2(o[0], o[1]); w.y = pk2(o[2], o[3]); w.z = pk2(o[4], o[5]); w.w = pk2(o[6], o[7]); *(GAS v4u*)(tdst + t0) = w; }
            if (fg >= 8) {
#pragma unroll
                for (int u = 0; u < 8; ++u) ndst[(size_t)(t0 + u) * SSD_N] = (bf16)f2bf(o[u]); }
        }
    }
}

__device__ __forceinline__ void p_attn_naive(Frame& F, const Args& A) {
    unsigned char* ws = A.ws;
    const bf16* QKV = (const bf16*)(ws + WS_QKV); bf16* MIX = (bf16*)(ws + WS_MIX);
    const long gt = (long)F.vcu * (NWAVES * 64) + F.tid, NT = (long)F.G * NWAVES * 64;
    for (long it = gt; it < (long)M * NH; it += NT) {
        const int h = (int)(it & 7), row = (int)(it >> 3), b = row >> 12, t = row & (SEQ - 1);
        float q[64], o[64];
        { const GAS v4u* qp = (const GAS v4u*)(QKV + (size_t)row * 1536 + h * 64);
#pragma unroll
          for (int c = 0; c < 8; ++c) { const v4u a = qp[c]; q[8 * c] = bflo(a.x); q[8 * c + 1] = bfhi(a.x); q[8 * c + 2] = bflo(a.y); q[8 * c + 3] = bfhi(a.y);
              q[8 * c + 4] = bflo(a.z); q[8 * c + 5] = bfhi(a.z); q[8 * c + 6] = bflo(a.w); q[8 * c + 7] = bfhi(a.w); } }
#pragma unroll
        for (int i = 0; i < 64; ++i) o[i] = 0.f;
        float mx = -INFINITY, l = 0.f;
        for (int br = 0; br < 3; ++br) {
            const int d = br == 0 ? 1 : (br == 1 ? 4 : 16);
            for (int j = 0; j <= 128; ++j) {
                const int tk = t - d * j; if (tk < 0) break;
                const size_t krow = (size_t)(b * SEQ + tk);
                const GAS v4u* kp = (const GAS v4u*)(QKV + krow * 1536 + 512 + h * 64);
                const GAS v4u* vp = (const GAS v4u*)(QKV + krow * 1536 + 1024 + h * 64);
                float s = 0.f;
#pragma unroll
                for (int c = 0; c < 8; ++c) { const v4u a = kp[c];
                    s += q[8 * c] * bflo(a.x) + q[8 * c + 1] * bfhi(a.x) + q[8 * c + 2] * bflo(a.y) + q[8 * c + 3] * bfhi(a.y)
                       + q[8 * c + 4] * bflo(a.z) + q[8 * c + 5] * bfhi(a.z) + q[8 * c + 6] * bflo(a.w) + q[8 * c + 7] * bfhi(a.w); }
                if (s > mx) { const float f = exp2f(mx - s); l *= f;
#pragma unroll
                    for (int i = 0; i < 64; ++i) o[i] *= f;
                    mx = s; }
                const float p = exp2f(s - mx); l += p;
#pragma unroll
                for (int c = 0; c < 8; ++c) { const v4u a = vp[c];
                    o[8 * c] += p * bflo(a.x); o[8 * c + 1] += p * bfhi(a.x); o[8 * c + 2] += p * bflo(a.y); o[8 * c + 3] += p * bfhi(a.y);
                    o[8 * c + 4] += p * bflo(a.z); o[8 * c + 5] += p * bfhi(a.z); o[8 * c + 6] += p * bflo(a.w); o[8 * c + 7] += p * bfhi(a.w); }
            }
        }
        const float rl = 1.0f / l;
        GAS v4u* dst = (GAS v4u*)(MIX + (size_t)row * 1024 + h * 64);
#pragma unroll
        for (int c = 0; c < 8; ++c) { v4u w; w.x = pk2(o[8 * c] * rl, o[8 * c + 1] * rl); w.y = pk2(o[8 * c + 2] * rl, o[8 * c + 3] * rl);
            w.z = pk2(o[8 * c + 4] * rl, o[8 * c + 5] * rl); w.w = pk2(o[8 * c + 6] * rl, o[8 * c + 7] * rl); dst[c] = w; }
    }
}

typedef short bf16x8v __attribute__((ext_vector_type(8)));
typedef float f32x16 __attribute__((ext_vector_type(16)));
__device__ __forceinline__ int sw256(int row, int chunk) { return row * 256 + ((chunk ^ (row & 15)) << 4); }
__device__ __forceinline__ void stage_tile128(LAS unsigned char* dst, const bf16* src, int pitch, int wave, int lane) {
#pragma unroll
    for (int i = 0; i < 4; ++i) { const int piece = wave * 4 + i, row = piece * 4 + (lane >> 4), slot = lane & 15, ch = slot ^ (row & 15);
        __builtin_amdgcn_global_load_lds((const unsigned*)(src + (size_t)row * pitch + ch * 8), (LAS unsigned*)(dst + piece * 1024), 16, 0, 0); }
}
__device__ __forceinline__ void chunk_cumsum(const float* DT, size_t row0, int h, float Ah, int lane, float& dt0, float& dt1, float& cs0, float& cs1, float& total) {
    dt0 = DT[(row0 + 2 * lane) * 8 + h]; dt1 = DT[(row0 + 2 * lane + 1) * 8 + h];
    const float a0 = dt0 * Ah, a1 = dt1 * Ah; float sc = a0 + a1;
#pragma unroll
    for (int off = 1; off < 64; off <<= 1) { const float t = __shfl_up(sc, off); if (lane >= off) sc += t; }
    cs1 = sc; cs0 = sc - a1; total = __shfl(sc, 63);
}

constexpr int S2_BT = 0, S2_WT = 32768;
__device__ __forceinline__ void p_ssd_states(Frame& F, const Args& A) {
    unsigned char* ws = A.ws;
    const bf16* XT = (const bf16*)(ws + WS_XT); const bf16* BT = (const bf16*)(ws + WS_BT); const float* DT = (const float*)(ws + WS_DT);
    bf16* ST = (bf16*)(ws + WS_ST); float* CHD = (float*)(ws + WS_CHD);
    const float* a_log = (const float*)A.in[9];
    const int lane = F.lane, h = F.wave, hi = lane >> 5, l31 = lane & 31;
    LAS unsigned char* lds = F.lds;
    LAS float* wt = (LAS float*)(lds + S2_WT) + h * CHUNK;
    for (int bc = F.vcu; bc < BATCH * NCHUNK; bc += F.G) {
        const size_t row0 = (size_t)bc * CHUNK;
        stage_tile128(lds + S2_BT, BT + (size_t)bc * SSD_N * CHUNK, CHUNK, h, lane);
        const float Ah = -expf(a_log[h]);
        float dt0, dt1, cs0, cs1, total; chunk_cumsum(DT, row0, h, Ah, lane, dt0, dt1, cs0, cs1, total);
        wt[2 * lane] = dt0 * expf(total - cs0); wt[2 * lane + 1] = dt1 * expf(total - cs1);
        if (lane == 0) CHD[bc * 8 + h] = expf(total);
        const bf16* xh = XT + (size_t)(bc * 8 + h) * 64 * CHUNK;
        v4u xr[2][8];
#pragma unroll
        for (int pt = 0; pt < 2; ++pt)
#pragma unroll
            for (int ks = 0; ks < 8; ++ks) xr[pt][ks] = *(const GAS v4u*)(xh + (size_t)(pt * 32 + l31) * CHUNK + 16 * ks + 8 * hi);
        asm volatile("s_waitcnt vmcnt(0) lgkmcnt(0)" ::: "memory"); __syncthreads();
        bf16x8v xa[2][8];
#pragma unroll
        for (int ks = 0; ks < 8; ++ks) {
            const f32x4 wa = *(const LAS f32x4*)(wt + 16 * ks + 8 * hi), wb = *(const LAS f32x4*)(wt + 16 * ks + 8 * hi + 4);
#pragma unroll
            for (int pt = 0; pt < 2; ++pt) { const v4u x = xr[pt][ks]; v4u o;
                o.x = pg8::cvt_pk_bf16(bflo(x.x) * wa.x, bfhi(x.x) * wa.y); o.y = pg8::cvt_pk_bf16(bflo(x.y) * wa.z, bfhi(x.y) * wa.w);
                o.z = pg8::cvt_pk_bf16(bflo(x.z) * wb.x, bfhi(x.z) * wb.y); o.w = pg8::cvt_pk_bf16(bflo(x.w) * wb.z, bfhi(x.w) * wb.w);
                xa[pt][ks] = __builtin_bit_cast(bf16x8v, o); }
        }
        bf16* sth = ST + (size_t)(bc * 8 + h) * 64 * SSD_N;
#pragma unroll 1
        for (int nt = 0; nt < 4; ++nt) {
            f32x16 acc0 = {}, acc1 = {};
#pragma unroll
            for (int ks = 0; ks < 8; ++ks) {
                const bf16x8v bfrag = *(const LAS bf16x8v*)(lds + S2_BT + sw256(nt * 32 + l31, 2 * ks + hi));
                acc0 = __builtin_amdgcn_mfma_f32_32x32x16_bf16(xa[0][ks], bfrag, acc0, 0, 0, 0);
                acc1 = __builtin_amdgcn_mfma_f32_32x32x16_bf16(xa[1][ks], bfrag, acc1, 0, 0, 0);
            }
#pragma unroll
            for (int r = 0; r < 16; ++r) { const int p = (r & 3) + 8 * (r >> 2) + 4 * hi;
                sth[(size_t)p * SSD_N + nt * 32 + l31] = (bf16)f2bf(acc0[r]); sth[(size_t)(32 + p) * SSD_N + nt * 32 + l31] = (bf16)f2bf(acc1[r]); }
        }
        __syncthreads();
    }
}

__device__ __forceinline__ void p_ssd_scan(Frame& F, const Args& A) {
    unsigned char* ws = A.ws;
    const bf16* ST = (const bf16*)(ws + WS_ST); bf16* PREV = (bf16*)(ws + WS_PREV); const float* CHD = (const float*)(ws + WS_CHD);
    const long gt = (long)F.vcu * (NWAVES * 64) + F.tid, NT = (long)F.G * NWAVES * 64;
    for (long e = gt; e < (long)BATCH * NH * HD * 32; e += NT) {
        const int n4 = (int)(e & 31), p = (int)(e >> 5) & 63, h = (int)(e >> 11) & 7, b = (int)(e >> 14);
        constexpr size_t CSTRIDE = (size_t)8 * 64 * SSD_N;
        const bf16* sp = ST + ((size_t)(b * NCHUNK * 8 + h) * 64 + p) * SSD_N + 4 * n4; bf16* pp = PREV + ((size_t)(b * NCHUNK * 8 + h) * 64 + p) * SSD_N + 4 * n4;
        const float* dp = CHD + (size_t)b * NCHUNK * 8 + h;
        float r0 = 0.f, r1 = 0.f, r2 = 0.f, r3 = 0.f;
#pragma unroll 1
        for (int c0 = 0; c0 < NCHUNK; c0 += 8) {
            v2u sv[8]; float dv[8];
#pragma unroll
            for (int c = 0; c < 8; ++c) { sv[c] = *(const GAS v2u*)(sp + c * CSTRIDE); dv[c] = dp[c * 8]; }
#pragma unroll
            for (int c = 0; c < 8; ++c) { v2u o; o.x = pk2(r0, r1); o.y = pk2(r2, r3); *(GAS v2u*)(pp + c * CSTRIDE) = o;
                r0 = r0 * dv[c] + bflo(sv[c].x); r1 = r1 * dv[c] + bfhi(sv[c].x); r2 = r2 * dv[c] + bflo(sv[c].y); r3 = r3 * dv[c] + bfhi(sv[c].y); }
            sp += 8 * CSTRIDE; pp += 8 * CSTRIDE; dp += 64;
        }
    }
}

constexpr int S4_CN = 0, S4_BN = 32768, S4_STG = 32768  , S4_G = 98304;
constexpr int S4_TAB = 131072 + 1024;
__device__ __forceinline__ void p_ssd_out(Frame& F, const Args& A) {
    unsigned char* ws = A.ws;
    const bf16* XT = (const bf16*)(ws + WS_XT); const bf16* BN = (const bf16*)(ws + WS_BN); const bf16* CN = (const bf16*)(ws + WS_CN); const bf16* PREV = (const bf16*)(ws + WS_PREV);
    const float* DT = (const float*)(ws + WS_DT); const bf16* Z = (const bf16*)(ws + WS_Z); bf16* MIX = (bf16*)(ws + WS_MIX);
    const float* a_log = (const float*)A.in[9]; const float* d_skip = (const float*)A.in[10]; const float* gn = (const float*)A.in[11];
    const int lane = F.lane, h = F.wave, hi = lane >> 5, l31 = lane & 31;
    LAS unsigned char* lds = F.lds;
    LAS float* cst = (LAS float*)(lds + S4_TAB) + h * CHUNK; LAS float* dtt = (LAS float*)(lds + S4_TAB + 4096) + h * CHUNK; LAS float* ect = (LAS float*)(lds + S4_TAB + 8192) + h * CHUNK;
    LAS float* rowsum = (LAS float*)(lds + S4_TAB + 12288);
    LAS float* stg = (LAS float*)(lds + S4_STG + h * 8192);
    const float Ah = -expf(a_log[h]), Dh = d_skip[h];
    for (int bc = F.vcu; bc < BATCH * NCHUNK; bc += F.G) {
        const size_t row0 = (size_t)bc * CHUNK;
        stage_tile128(lds + S4_CN, CN + row0 * SSD_N, SSD_N, h, lane);
        stage_tile128(lds + S4_BN, BN + row0 * SSD_N, SSD_N, h, lane);
        { float dt0, dt1, cs0, cs1, total; chunk_cumsum(DT, row0, h, Ah, lane, dt0, dt1, cs0, cs1, total);
          *(LAS f32x2v*)(cst + 2 * lane) = (f32x2v){cs0, cs1}; *(LAS f32x2v*)(dtt + 2 * lane) = (f32x2v){dt0, dt1}; *(LAS f32x2v*)(ect + 2 * lane) = (f32x2v){expf(cs0), expf(cs1)}; }
        const bf16* xh = XT + (size_t)(bc * 8 + h) * 64 * CHUNK; const bf16* ph = PREV + (size_t)(bc * 8 + h) * 64 * SSD_N;
        bf16x8v xb[2][8];
#pragma unroll
        for (int pt = 0; pt < 2; ++pt)
#pragma unroll
            for (int ks = 0; ks < 8; ++ks) xb[pt][ks] = *(const GAS bf16x8v*)(xh + (size_t)(pt * 32 + l31) * CHUNK + 16 * ks + 8 * hi);
        asm volatile("s_waitcnt vmcnt(0) lgkmcnt(0)" ::: "memory"); __syncthreads();
        for (int ti = h; ti < 10; ti += 8) {
            const int lt = (int)((0x3333222110ull >> (4 * ti)) & 15), st = (int)((0x3210210100ull >> (4 * ti)) & 15);
            f32x16 acc = {};
#pragma unroll
            for (int ks = 0; ks < 8; ++ks) {
                const bf16x8v a = *(const LAS bf16x8v*)(lds + S4_CN + sw256(lt * 32 + l31, 2 * ks + hi));
                const bf16x8v b = *(const LAS bf16x8v*)(lds + S4_BN + sw256(st * 32 + l31, 2 * ks + hi));
                acc = __builtin_amdgcn_mfma_f32_32x32x16_bf16(a, b, acc, 0, 0, 0);
            }
            const int scol = st * 32 + l31;
#pragma unroll
            for (int r = 0; r < 16; ++r) { const int l = lt * 32 + (r & 3) + 8 * (r >> 2) + 4 * hi;
                *(LAS unsigned short*)(lds + S4_G + sw256(l, scol >> 3) + (scol & 7) * 2) = (unsigned short)f2bf(acc[r]); }
        }
        asm volatile("s_waitcnt lgkmcnt(0)" ::: "memory"); __syncthreads();
#pragma unroll
        for (int lt = 0; lt < 4; ++lt) {
            f32x16 acc0 = {}, acc1 = {};
#pragma unroll 1
            for (int kh = 0; kh < 2; ++kh) {
                bf16x8v pf[2][4];
#pragma unroll
                for (int pt = 0; pt < 2; ++pt)
#pragma unroll
                    for (int k4 = 0; k4 < 4; ++k4) pf[pt][k4] = *(const GAS bf16x8v*)(ph + (size_t)(pt * 32 + l31) * SSD_N + 16 * (4 * kh + k4) + 8 * hi);
#pragma unroll
                for (int k4 = 0; k4 < 4; ++k4) {
                    const bf16x8v a = *(const LAS bf16x8v*)(lds + S4_CN + sw256(lt * 32 + l31, 2 * (4 * kh + k4) + hi));
                    acc0 = __builtin_amdgcn_mfma_f32_32x32x16_bf16(a, pf[0][k4], acc0, 0, 0, 0);
                    acc1 = __builtin_amdgcn_mfma_f32_32x32x16_bf16(a, pf[1][k4], acc1, 0, 0, 0);
                }
            }
#pragma unroll
            for (int q = 0; q < 4; ++q) { const f32x4 e = *(const LAS f32x4*)(ect + lt * 32 + 8 * q + 4 * hi);
#pragma unroll
                for (int j = 0; j < 4; ++j) { acc0[4 * q + j] *= e[j]; acc1[4 * q + j] *= e[j]; } }
            const int lrow = lt * 32 + l31; const float csl = cst[lrow];
#pragma unroll
            for (int st = 0; st < 4; ++st) { if (st > lt) break;
#pragma unroll
                for (int ks2 = 0; ks2 < 2; ++ks2) {
                    const int s0 = st * 32 + 16 * ks2 + 8 * hi;
                    const v4u gq = *(const LAS v4u*)(lds + S4_G + sw256(lrow, st * 4 + 2 * ks2 + hi));
                    const f32x4 ca = *(const LAS f32x4*)(cst + s0), cb = *(const LAS f32x4*)(cst + s0 + 4), da = *(const LAS f32x4*)(dtt + s0), db = *(const LAS f32x4*)(dtt + s0 + 4);
                    float m[8];
                    m[0] = bflo(gq.x) * __expf(csl - ca.x) * da.x; m[1] = bfhi(gq.x) * __expf(csl - ca.y) * da.y; m[2] = bflo(gq.y) * __expf(csl - ca.z) * da.z; m[3] = bfhi(gq.y) * __expf(csl - ca.w) * da.w;
                    m[4] = bflo(gq.z) * __expf(csl - cb.x) * db.x; m[5] = bfhi(gq.z) * __expf(csl - cb.y) * db.y; m[6] = bflo(gq.w) * __expf(csl - cb.z) * db.z; m[7] = bfhi(gq.w) * __expf(csl - cb.w) * db.w;
                    if (st == lt) {
#pragma unroll
                        for (int j = 0; j < 8; ++j) { m[j] = (s0 + j > lrow) ? 0.f : m[j]; m[j] = (s0 + j == lrow) ? m[j] + Dh : m[j]; } }
                    v4u mo; mo.x = pg8::cvt_pk_bf16(m[0], m[1]); mo.y = pg8::cvt_pk_bf16(m[2], m[3]); mo.z = pg8::cvt_pk_bf16(m[4], m[5]); mo.w = pg8::cvt_pk_bf16(m[6], m[7]);
                    const bf16x8v mf = __builtin_bit_cast(bf16x8v, mo);
                    const bf16x8v x0 = xb[0][2 * st + ks2], x1 = xb[1][2 * st + ks2];
                    acc0 = __builtin_amdgcn_mfma_f32_32x32x16_bf16(mf, x0, acc0, 0, 0, 0);
                    acc1 = __builtin_amdgcn_mfma_f32_32x32x16_bf16(mf, x1, acc1, 0, 0, 0);
                }
            }
#pragma unroll
            for (int r = 0; r < 16; ++r) { const int rr = (r & 3) + 8 * (r >> 2) + 4 * hi; stg[rr * 64 + l31] = acc0[r]; stg[rr * 64 + 32 + l31] = acc1[r]; }
            asm volatile("s_waitcnt lgkmcnt(0)" ::: "memory");
            float v[4][8];
#pragma unroll
            for (int i = 0; i < 4; ++i) { const int row = i * 8 + (lane >> 3), c0 = 8 * (lane & 7);
                const f32x4 ya = *(const LAS f32x4*)(stg + row * 64 + c0), yb = *(const LAS f32x4*)(stg + row * 64 + c0 + 4);
                const v4u zz = *(const GAS v4u*)(Z + (row0 + lt * 32 + row) * 512 + h * 64 + c0);
                v[i][0] = ya.x * bflo(zz.x); v[i][1] = ya.y * bfhi(zz.x); v[i][2] = ya.z * bflo(zz.y); v[i][3] = ya.w * bfhi(zz.y);
                v[i][4] = yb.x * bflo(zz.z); v[i][5] = yb.y * bfhi(zz.z); v[i][6] = yb.z * bflo(zz.w); v[i][7] = yb.w * bfhi(zz.w);
                float ss = 0.f;
#pragma unroll
                for (int e = 0; e < 8; ++e) ss += v[i][e] * v[i][e];
                ss += __shfl_xor(ss, 1); ss += __shfl_xor(ss, 2); ss += __shfl_xor(ss, 4);
                if ((lane & 7) == 0) rowsum[(lt * 32 + row) * 8 + h] = ss; }
            asm volatile("s_waitcnt lgkmcnt(0)" ::: "memory"); __syncthreads();
#pragma unroll
            for (int i = 0; i < 4; ++i) { const int row = i * 8 + (lane >> 3), c0 = 8 * (lane & 7);
                const f32x4 sa = *(const LAS f32x4*)(rowsum + (lt * 32 + row) * 8), sb = *(const LAS f32x4*)(rowsum + (lt * 32 + row) * 8 + 4);
                const float tot = ((sa.x + sa.y) + (sa.z + sa.w)) + ((sb.x + sb.y) + (sb.z + sb.w));
                const float rstd = 1.0f / sqrtf(tot * (1.f / 512.f) + EPS);
                const f32x4 g0 = *(const GAS f32x4*)(gn + h * 64 + c0), g1 = *(const GAS f32x4*)(gn + h * 64 + c0 + 4);
                v4u w; w.x = pg8::cvt_pk_bf16(v[i][0] * rstd * g0.x, v[i][1] * rstd * g0.y); w.y = pg8::cvt_pk_bf16(v[i][2] * rstd * g0.z, v[i][3] * rstd * g0.w);
                w.z = pg8::cvt_pk_bf16(v[i][4] * rstd * g1.x, v[i][5] * rstd * g1.y); w.w = pg8::cvt_pk_bf16(v[i][6] * rstd * g1.z, v[i][7] * rstd * g1.w);
                *(GAS v4u*)(MIX + (row0 + lt * 32 + row) * 1024 + 512 + h * 64 + c0) = w; }
        }
        __syncthreads();
    }
}

__device__ __forceinline__ void p_ssd_naive(Frame& F, const Args& A) {
    unsigned char* ws = A.ws;
    const bf16* XT = (const bf16*)(ws + WS_XT); const bf16* BN = (const bf16*)(ws + WS_BN); const bf16* CN = (const bf16*)(ws + WS_CN); const bf16* PREV = (const bf16*)(ws + WS_PREV);
    const float* DT = (const float*)(ws + WS_DT); float* Y = (float*)(ws + WS_Y);
    const float* a_log = (const float*)A.in[9]; const float* d_skip = (const float*)A.in[10];
    const int gw = F.vcu * NWAVES + F.wave, NGW = F.G * NWAVES, lane = F.lane;
    for (int it = gw; it < BATCH * NCHUNK * NH * HD; it += NGW) {
        const int bc = it >> 9, h = (it >> 6) & 7, p = it & 63;
        const float Ah = -expf(a_log[h]), Dh = d_skip[h];
        const unsigned pv = *(const GAS unsigned*)(PREV + ((size_t)(bc * 8 + h) * 64 + p) * SSD_N + 2 * lane);
        float h0 = bflo(pv), h1 = bfhi(pv);
        for (int l0 = 0; l0 < CHUNK; l0 += 8) {
            float dtv[8], xv[8]; unsigned Bv[8], Cv[8];
            const v4u xx = *(const GAS v4u*)(XT + ((size_t)(bc * 8 + h) * 64 + p) * CHUNK + l0);
            xv[0] = bflo(xx.x); xv[1] = bfhi(xx.x); xv[2] = bflo(xx.y); xv[3] = bfhi(xx.y); xv[4] = bflo(xx.z); xv[5] = bfhi(xx.z); xv[6] = bflo(xx.w); xv[7] = bfhi(xx.w);
#pragma unroll
            for (int u = 0; u < 8; ++u) { const size_t row = (size_t)bc * CHUNK + l0 + u;
                dtv[u] = DT[row * 8 + h];
                Bv[u] = *(const GAS unsigned*)(BN + row * SSD_N + 2 * lane); Cv[u] = *(const GAS unsigned*)(CN + row * SSD_N + 2 * lane); }
#pragma unroll
            for (int u = 0; u < 8; ++u) { const float dec = expf(dtv[u] * Ah), xdt = xv[u] * dtv[u];
                h0 = dec * h0 + bflo(Bv[u]) * xdt; h1 = dec * h1 + bfhi(Bv[u]) * xdt;
                const float y = wave_sum(bflo(Cv[u]) * h0 + bfhi(Cv[u]) * h1);
                if (lane == 0) Y[((size_t)bc * CHUNK + l0 + u) * 512 + h * 64 + p] = y + Dh * xv[u]; }
        }
    }
}

__device__ __forceinline__ void p_gate_naive(Frame& F, const Args& A) {
    unsigned char* ws = A.ws;
    const float* Y = (const float*)(ws + WS_Y); const bf16* Z = (const bf16*)(ws + WS_Z); bf16* MIX = (bf16*)(ws + WS_MIX);
    const float* g = (const float*)A.in[11];
    const int gw = F.vcu * NWAVES + F.wave, NGW = F.G * NWAVES, lane = F.lane;
    for (int m = gw; m < M; m += NGW) {
        const GAS f32x4* yp = (const GAS f32x4*)(Y + (size_t)m * 512 + 8 * lane); const f32x4 y0 = yp[0], y1 = yp[1];
        const v4u z = *(const GAS v4u*)(Z + (size_t)m * 512 + 8 * lane);
        float v[8]; v[0] = y0.x * bflo(z.x); v[1] = y0.y * bfhi(z.x); v[2] = y0.z * bflo(z.y); v[3] = y0.w * bfhi(z.y);
        v[4] = y1.x * bflo(z.z); v[5] = y1.y * bfhi(z.z); v[6] = y1.z * bflo(z.w); v[7] = y1.w * bfhi(z.w);
        float ss = 0.f;
#pragma unroll
        for (int e = 0; e < 8; ++e) ss += v[e] * v[e];
        const float rstd = 1.0f / sqrtf(wave_sum(ss) * (1.f / 512.f) + EPS);
        const GAS f32x4* gp = (const GAS f32x4*)(g + 8 * lane); const f32x4 g0 = gp[0], g1 = gp[1];
        v4u w; w.x = pk2(v[0] * rstd * g0.x, v[1] * rstd * g0.y); w.y = pk2(v[2] * rstd * g0.z, v[3] * rstd * g0.w);
        w.z = pk2(v[4] * rstd * g1.x, v[5] * rstd * g1.y); w.w = pk2(v[6] * rstd * g1.z, v[7] * rstd * g1.w);
        *(GAS v4u*)(MIX + (size_t)m * 1024 + 512 + 8 * lane) = w;
    }
}

template <int MODE> __device__ __forceinline__ void p_rows(Frame& F, const Args& A, const float* ga, const float* gb) {
    unsigned char* ws = A.ws;
    const float* T = (const float*)(ws + WS_T); const float* x = (const float*)A.in[0]; float* out = A.out;
    bf16* XN = (bf16*)(ws + WS_XN); const bf16* SIG = (const bf16*)(ws + WS_SIG);
    const int gw = F.vcu * NWAVES + F.wave, NGW = F.G * NWAVES, lane = F.lane;
    for (int m = gw; m < M; m += NGW) {
        const GAS f32x4* tr = (const GAS f32x4*)(T + (size_t)m * DM) + lane;
        const GAS f32x4* br = (const GAS f32x4*)((MODE == 0 ? x : (const float*)out) + (size_t)m * DM) + lane;
        GAS f32x4* orow = (GAS f32x4*)(out + (size_t)m * DM) + lane;
        f32x4 v[4], bs[4]; float ss = 0.f;
#pragma unroll
        for (int j = 0; j < 4; ++j) { v[j] = tr[64 * j]; bs[j] = br[64 * j];
            if (MODE == 2) { const v2u s = *((const GAS v2u*)(SIG + (size_t)m * DM) + lane + 64 * j); v[j].x *= bflo(s.x); v[j].y *= bfhi(s.x); v[j].z *= bflo(s.y); v[j].w *= bfhi(s.y); }
            ss += (v[j].x * v[j].x + v[j].y * v[j].y) + (v[j].z * v[j].z + v[j].w * v[j].w); }
        const float rstd = 1.0f / sqrtf(wave_sum(ss) * (1.f / DM) + EPS);
        float s2 = 0.f;
#pragma unroll
        for (int j = 0; j < 4; ++j) { const f32x4 g = *((const GAS f32x4*)ga + lane + 64 * j);
            v[j] = bs[j] + v[j] * rstd * g; orow[64 * j] = v[j];
            s2 += (v[j].x * v[j].x + v[j].y * v[j].y) + (v[j].z * v[j].z + v[j].w * v[j].w); }
        if (MODE == 0) {
            const float r2 = 1.0f / sqrtf(wave_sum(s2) * (1.f / DM) + EPS);
            GAS unsigned long long* o8 = (GAS unsigned long long*)(XN + (size_t)m * DM) + lane;
#pragma unroll
            for (int j = 0; j < 4; ++j) { const f32x4 g = *((const GAS f32x4*)gb + lane + 64 * j); const f32x4 u = v[j] * r2 * g;
                o8[64 * j] = (unsigned long long)pk2(u.x, u.y) | ((unsigned long long)pk2(u.z, u.w) << 32); }
        } else if (MODE == 1) {
            GAS unsigned long long* o8 = (GAS unsigned long long*)(XN + (size_t)m * DM) + lane;
#pragma unroll
            for (int j = 0; j < 4; ++j) o8[64 * j] = (unsigned long long)pk2(v[j].x, v[j].y) | ((unsigned long long)pk2(v[j].z, v[j].w) << 32);
        }
    }
}
template <int ACT, bool OUTBF> __device__ __forceinline__ void p_check_gemm(Frame& F, const bf16* Amat, const bf16* Bt, int K, int N, const void* C, int id) {
    const long gt = (long)F.vcu * (NWAVES * 64) + F.tid;
    unsigned hsh = (unsigned)gt * 2654435761u + 12345u * (unsigned)(id + 1);
    for (int s = 0; s < 16; ++s) {
        hsh = hsh * 1664525u + 1013904223u; const int row = (int)((hsh >> 8) % (unsigned)M);
        hsh = hsh * 1664525u + 1013904223u; const int col = (int)((hsh >> 8) % (unsigned)N);
        float acc = 0.f;
        for (int k = 0; k < K; ++k) acc += bf2f(Amat[(size_t)row * K + k]) * bf2f(Bt[(size_t)col * K + k]);
        acc = pg8::act_apply(ACT, acc);
        const float got = OUTBF ? bf2f(((const bf16*)C)[(size_t)row * N + col]) : ((const float*)C)[(size_t)row * N + col];
        const float err = fabsf(got - acc);
        if (!(err <= 0.02f * fabsf(acc) + 0.02f)) atomicAdd((unsigned*)(F.ctl + 64 + id), 1u);
    }
}

__global__ void __launch_bounds__(NWAVES * 64, 2) mk_fwd(Args args) {
    extern __shared__ __attribute__((aligned(16))) unsigned char lds[];
    Frame F;
    F.lds = (LAS unsigned char*)lds;
    F.MISC = (volatile LAS unsigned*)(F.lds + MISC_OFF);
    F.tid = threadIdx.x; F.lane = F.tid & 63; F.wave = __builtin_amdgcn_readfirstlane(F.tid >> 6);
    F.G = gridDim.x; { const int bx = blockIdx.x; F.vcu = (F.G % 8 == 0) ? (bx % 8) * (F.G / 8) + bx / 8 : bx; }
    unsigned char* ws = args.ws;
    F.ctl = (gu32*)(ws + WS_CTL);
    for (int u = F.tid; u < (LDS_BYTES - LDSCTL_OFF) / 4; u += NWAVES * 64) ((LAS unsigned*)(F.lds + LDSCTL_OFF))[u] = 0u;
    __syncthreads();
    XcdBarrier bar = xcd_barrier_post((unsigned*)(F.ctl + CW_BAR), F.MISC + 8);
#define BAR() xcd_barrier(bar)
#define GEMM_PHASE(EPI, Aoff, Boff, N_, K_, ...) do { pg8::Gemm g{(const bf16*)(ws + (Aoff)), (const bf16*)(ws + (Boff)), M, (N_), (K_)}; pg8::StaticOrder S; S.init(M, (N_), F.G, (int)blockIdx.x); \
        EPI E{__VA_ARGS__}; pg8::gemm_phase<EPI, pg8::StaticOrder, true, true>(F.lds + RING_OFF, g, S, E); } while (0)

    p0_prologue(F, args); BAR();
    GEMM_PHASE(pg8::EpiBf16<0>, WS_XN, WS_WIN, NPROJ, DM, (bf16*)(ws + WS_PROJ), NPROJ); BAR();
    p_split(F, args); BAR();
    p_conv(F, args); p_attn_naive(F, args); BAR();
    p_ssd_states(F, args); BAR();
    p_ssd_scan(F, args); BAR();
    p_ssd_out(F, args); BAR();
    GEMM_PHASE(pg8::EpiF32, WS_MIX, WS_WOUT, DM, DM, (float*)(ws + WS_T), DM); BAR();
    p_rows<0>(F, args, (const float*)args.in[4], (const float*)args.in[13]); BAR();
    GEMM_PHASE(pg8::EpiBf16<2>, WS_XN, WS_WUP, FF, DM, (bf16*)(ws + WS_H), FF); BAR();
    GEMM_PHASE(pg8::EpiF32, WS_H, WS_WDN, DM, FF, (float*)(ws + WS_T), DM); BAR();
    p_rows<1>(F, args, (const float*)args.in[14], nullptr); BAR();
    GEMM_PHASE(pg8::EpiBf16<3>, WS_XN, WS_WG, DM, DM, (bf16*)(ws + WS_SIG), DM); BAR();
    GEMM_PHASE(pg8::EpiF32, WS_PB, WS_WP, DM, PLE, (float*)(ws + WS_T), DM); BAR();
    p_rows<2>(F, args, (const float*)args.in[19], nullptr);
#undef BAR
#undef GEMM_PHASE
}

extern "C" void kernel_launch(void* const* d_in, const int* in_sizes, int n_in, void* d_out, int out_size, void* d_ws, size_t ws_size, hipStream_t stream) {
    static int grid = 0;
    if (grid == 0) {
        if (n_in != 20 || in_sizes[0] != M * DM || out_size != M * DM || ws_size < WS_END) {
            fprintf(stderr, "kernel_launch: unexpected shapes: n_in %d in0 %d out %d ws %zu; nothing launched\n", n_in, n_in > 0 ? in_sizes[0] : -1, out_size, ws_size); grid = -1; return; }
        int dev = 0, cus = 0, per_cu = 0;
        if (hipGetDevice(&dev) != hipSuccess || hipDeviceGetAttribute(&cus, hipDeviceAttributeMultiprocessorCount, dev) != hipSuccess) { grid = -1; return; }
        if (hipFuncSetAttribute((const void*)mk_fwd, hipFuncAttributeMaxDynamicSharedMemorySize, LDS_BYTES) != hipSuccess) { fprintf(stderr, "kernel_launch: hipFuncSetAttribute failed\n"); grid = -1; return; }
        if (hipOccupancyMaxActiveBlocksPerMultiprocessor(&per_cu, (const void*)mk_fwd, NWAVES * 64, LDS_BYTES) != hipSuccess || per_cu < 1) {
            fprintf(stderr, "kernel_launch: occupancy query reports %d blocks per CU\n", per_cu); }
        (void)hipGetLastError();
        grid = cus;
    }
    if (grid < 0) return;
    (void)hipMemsetAsync((char*)d_ws + WS_CTL, 0, CTL_ZERO_BYTES, stream);
    Args a{};
    for (int i = 0; i < 20; ++i) a.in[i] = d_in[i];
    a.out = (float*)d_out; a.ws = (unsigned char*)d_ws;
    for (int i = 0; i < 32; ++i) a.inv_freq[i] = (float)pow(10000.0, -(double)i / 32.0);
    hipLaunchKernelGGL(mk_fwd, dim3(grid), dim3(NWAVES * 64), LDS_BYTES, stream, a);
}
```

```cpp
#include <hip/hip_bf16.h>
#include <cmath>
#include <hip/hip_runtime.h>
#include <cstdio>
#include <cstdint>
namespace pg8 {
#define PG8_LAS __attribute__((address_space(3)))
typedef unsigned short bf16_t;
typedef short bf16x8 __attribute__((ext_vector_type(8)));
typedef float f32x4 __attribute__((ext_vector_type(4)));
typedef unsigned u32x4 __attribute__((ext_vector_type(4)));
constexpr int BM = 256, BK = 64, HALF = 128, HTB = HALF * BK * 2  , STAGE_BYTES = 8 * HTB, NXCD = 8, WGM = 8;

__host__ __device__ __forceinline__ int lds_byte(int r, int c) { const int st = (r >> 4) * 2 + (c >> 5), rr = r & 15, cc = c & 31, ob = rr * 64 + cc * 2; return st * 1024 + (ob ^ (((ob >> 9) & 1) << 5)); }
__host__ __device__ __forceinline__ void stage_rc(int b, int& R, int& C) { const int st = b / 1024, sb = b % 1024, swz = sb ^ (((sb >> 9) & 1) << 5); R = (st >> 1) * 16 + swz / 64; C = (st & 1) * 32 + (swz % 64) / 2; }
__host__ __device__ __forceinline__ int perm32(int rho) { const int n = rho >> 4, i = rho & 15; return 8 * (i >> 2) + 4 * n + (i & 3); }

struct Unit { int pm, pn; };
struct Gemm { const bf16_t* A; const bf16_t* Bt; int M, N, K; };

struct StaticOrder {
    int nM, nN, nwg, G, c;
    __host__ __device__ void init(int M, int N, int G_, int c_) { nM = M / BM; nN = N / BM; nwg = nM * nN; G = G_; c = c_; }
    __host__ __device__ bool next(int i, Unit& u) const {
        const long L = (long)i * G + c; if (L >= nwg) return false;
        int wgid = (int)L; { const int q = nwg / NXCD, r = nwg % NXCD, xcd = wgid % NXCD, off = wgid / NXCD; wgid = (xcd < r ? xcd * (q + 1) : r * (q + 1) + (xcd - r) * q) + off; }
        const int nig = WGM * nN, gid = wgid / nig, fm = gid * WGM, gsz = (nM - fm) < WGM ? (nM - fm) : WGM;
        u.pm = fm + ((wgid % nig) % gsz); u.pn = (wgid % nig) / gsz; return true;
    }
    __device__ __forceinline__ void a_ready(const Unit&) const {}
    __device__ __forceinline__ void done(const Unit&) const {}
};


typedef float f32x2 __attribute__((ext_vector_type(2))); typedef __bf16 bf16x2_t __attribute__((ext_vector_type(2)));
__device__ __forceinline__ unsigned cvt_pk_bf16(float lo, float hi) { const f32x2 v = {lo, hi}; const bf16x2_t b = __builtin_convertvector(v, bf16x2_t); return __builtin_bit_cast(unsigned, b); }

__device__ __forceinline__ float act_apply(int ACT, float v) {
    if (ACT == 2) { const float r = v > 0.f ? v : 0.f; return r * r; }
    if (ACT == 3) { return __builtin_amdgcn_rcpf(1.0f + __builtin_amdgcn_exp2f(-1.4426950408889634f * v)); }
    return v;
}
template <int ACT> struct EpiBf16 {
    static constexpr bool PERM = true, AFTER_DRAIN = false;
    bf16_t* O; int ldc;
    __device__ __forceinline__ void operator()(const f32x4 (&acc)[2][2][4][2], const Unit& u, int wr, int wc, int fr, int fq) const {
        const int row0 = u.pm * BM + wr * 64 + fr; const int col0 = u.pn * BM + wc * 32 + 8 * fq;
#pragma unroll
        for (int ai = 0; ai < 2; ++ai)
#pragma unroll
            for (int m = 0; m < 4; ++m) { bf16_t* rowp = O + (size_t)(row0 + ai * HALF + m * 16) * ldc + col0;
#pragma unroll
                for (int bj = 0; bj < 2; ++bj) { f32x4 v0 = acc[ai][bj][m][0], v1 = acc[ai][bj][m][1];
#pragma unroll
                    for (int e = 0; e < 4; ++e) { v0[e] = act_apply(ACT, v0[e]); v1[e] = act_apply(ACT, v1[e]); }
                    u32x4 w; w.x = cvt_pk_bf16(v0[0], v0[1]); w.y = cvt_pk_bf16(v0[2], v0[3]); w.z = cvt_pk_bf16(v1[0], v1[1]); w.w = cvt_pk_bf16(v1[2], v1[3]);
                    *(u32x4*)(rowp + bj * HALF) = w; } }
    }
};
struct EpiF32 {
    static constexpr bool PERM = false, AFTER_DRAIN = false;
    float* O; int ldc;
    __device__ __forceinline__ void operator()(const f32x4 (&acc)[2][2][4][2], const Unit& u, int wr, int wc, int fr, int fq) const {
        const int row0 = u.pm * BM + wr * 64 + fr; const int col0 = u.pn * BM + wc * 32 + 4 * fq;
#pragma unroll
        for (int ai = 0; ai < 2; ++ai)
#pragma unroll
            for (int m = 0; m < 4; ++m) { float* rowp = O + (size_t)(row0 + ai * HALF + m * 16) * ldc + col0;
#pragma unroll
                for (int bj = 0; bj < 2; ++bj)
#pragma unroll
                    for (int n = 0; n < 2; ++n) *(f32x4*)(rowp + bj * HALF + n * 16) = acc[ai][bj][m][n]; }
    }
};
template <class Epi, class Sched, bool ALIGN_EPI = false, bool SP2 = false>
__device__ __forceinline__ void gemm_phase(PG8_LAS unsigned char* lds, const Gemm g, const Sched& S, const Epi& E) {
    const int tid = threadIdx.x, wid = __builtin_amdgcn_readfirstlane(tid >> 6), lane = tid & 63, wr = wid >> 2, wc = wid & 3, fr = lane & 15, fq = lane >> 4;
    const int K = g.K, nt = K / BK;
    unsigned voffA[2], voffB[2];
#pragma unroll
    for (int i = 0; i < 2; ++i) { int R, C; stage_rc(tid * 16 + i * 8192, R, C); const int Rb = Epi::PERM ? ((R & ~31) + perm32(R & 31)) : R;
        voffA[i] = (unsigned)(R * K + C) * 2u; voffB[i] = (unsigned)(Rb * K + C) * 2u; }
    const size_t kstep = (size_t)(BK * 2);
    const size_t hstep = (size_t)HALF * K * 2;
    const size_t tstep = 2 * hstep;
    const unsigned ldsw = (unsigned)wid * 1024u;
    const int aoff = lds_byte(wr * 64 + fr, fq * 8), boff = lds_byte(wc * 32 + fr, fq * 8);
#define PG8_SA(b, h) (((b) * 2 + (h)) * HTB)
#define PG8_SB(b, h) ((4 + (b) * 2 + (h)) * HTB)
#define PG8_STAGE(bufoff, gbase, voff) do { _Pragma("unroll") for (int _i = 0; _i < 2; ++_i) \
        __builtin_amdgcn_global_load_lds((const unsigned*)((const char*)(gbase) + (voff)[_i]), (PG8_LAS unsigned*)(lds + (bufoff) + ldsw + _i * 8192), 16, 0, 0); } while (0)
#define PG8_LDA(dst, b, h) do { _Pragma("unroll") for (int m = 0; m < 4; ++m) _Pragma("unroll") for (int k = 0; k < 2; ++k) dst[m][k] = *(const PG8_LAS bf16x8*)(lds + PG8_SA(b, h) + aoff + m * 2048 + k * 1024); } while (0)
#define PG8_LDB(dst, b, h) do { _Pragma("unroll") for (int n = 0; n < 2; ++n) _Pragma("unroll") for (int k = 0; k < 2; ++k) dst[n][k] = *(const PG8_LAS bf16x8*)(lds + PG8_SB(b, h) + boff + n * 2048 + k * 1024); } while (0)
#define PG8_MMA(ai, bj, At, Bt) do { __builtin_amdgcn_s_setprio(1); _Pragma("unroll") for (int m = 0; m < 4; ++m) _Pragma("unroll") for (int n = 0; n < 2; ++n) _Pragma("unroll") for (int k = 0; k < 2; ++k) \
        acc[ai][bj][m][n] = __builtin_amdgcn_mfma_f32_16x16x32_bf16(Bt[n][k], At[m][k], acc[ai][bj][m][n], 0, 0, 0); __builtin_amdgcn_s_setprio(0); } while (0)
#define PG8_WAIT_V(n) asm volatile("s_waitcnt vmcnt(" #n ")" ::: "memory")
#define PG8_WAIT_L(n) asm volatile("s_waitcnt lgkmcnt(" #n ")" ::: "memory")
#define PG8_BAR __builtin_amdgcn_s_barrier()
#define PG8_SCHED __builtin_amdgcn_sched_barrier(0)
    Unit cur, nxt; int ui = 0;
    if (!S.next(0, cur)) return;
    f32x4 acc[2][2][4][2];
#pragma unroll
    for (int a = 0; a < 2; ++a)
#pragma unroll
        for (int b = 0; b < 2; ++b)
#pragma unroll
            for (int m = 0; m < 4; ++m)
#pragma unroll
                for (int n = 0; n < 2; ++n) acc[a][b][m][n] = (f32x4){0.f, 0.f, 0.f, 0.f};
    bf16x8 At[4][2], B0[2][2], B1[2][2];
    const char* cA = (const char*)g.A + (size_t)cur.pm * tstep; const char* cB = (const char*)g.Bt + (size_t)cur.pn * tstep;
    S.a_ready(cur);
    if constexpr (SP2) {
        PG8_STAGE(PG8_SB(0, 0), cB, voffB); PG8_STAGE(PG8_SB(0, 1), cB + hstep, voffB); PG8_STAGE(PG8_SA(0, 0), cA, voffA); PG8_STAGE(PG8_SA(0, 1), cA + hstep, voffA);
        if (wr == 1) PG8_BAR;
        PG8_WAIT_V(2); PG8_BAR;
        PG8_STAGE(PG8_SB(1, 0), cB + kstep, voffB); PG8_STAGE(PG8_SA(1, 0), cA + kstep, voffA); PG8_STAGE(PG8_SB(1, 1), cB + hstep + kstep, voffB);
        PG8_WAIT_V(6); PG8_BAR;
    } else {
        PG8_STAGE(PG8_SB(0, 0), cB, voffB); PG8_STAGE(PG8_SA(0, 0), cA, voffA); PG8_STAGE(PG8_SB(0, 1), cB + hstep, voffB); PG8_STAGE(PG8_SA(0, 1), cA + hstep, voffA);
        if (wr == 1) PG8_BAR;
        PG8_WAIT_V(4); PG8_BAR;
        PG8_STAGE(PG8_SB(1, 0), cB + kstep, voffB); PG8_STAGE(PG8_SA(1, 0), cA + kstep, voffA); PG8_STAGE(PG8_SB(1, 1), cB + hstep + kstep, voffB);
        PG8_WAIT_V(6); PG8_BAR;
    }
    for (;;) {
        const bool has_next = S.next(ui + 1, nxt);
        const char* nA = has_next ? (const char*)g.A + (size_t)nxt.pm * tstep : cA; const char* nB = has_next ? (const char*)g.Bt + (size_t)nxt.pn * tstep : cB;
        for (int t = 0; t < nt; t += 2) {
            const bool last = (t == nt - 2);
            const char* a1 = cA + (size_t)(t + 1) * kstep;
            const char* a2 = last ? nA : cA + (size_t)(t + 2) * kstep; const char* b2 = last ? nB : cB + (size_t)(t + 2) * kstep;
            const char* a3 = a2 + kstep; const char* b3 = b2 + kstep;
            if (last && has_next) S.a_ready(nxt);
            if constexpr (SP2) {
            PG8_LDB(B0, 0, 0); PG8_LDB(B1, 0, 1); PG8_SCHED; PG8_LDA(At, 0, 0); PG8_STAGE(PG8_SA(1, 1), a1 + hstep, voffA);
            PG8_WAIT_V(8); PG8_WAIT_L(0); PG8_BAR; PG8_MMA(0, 0, At, B0); PG8_MMA(0, 1, At, B1); PG8_BAR; PG8_SCHED;
            PG8_LDA(At, 0, 1); PG8_STAGE(PG8_SB(0, 0), b2, voffB); PG8_STAGE(PG8_SB(0, 1), b2 + hstep, voffB); PG8_STAGE(PG8_SA(0, 0), a2, voffA);
            PG8_WAIT_V(8); PG8_WAIT_L(0); PG8_BAR; PG8_MMA(1, 0, At, B0); PG8_MMA(1, 1, At, B1); PG8_BAR; PG8_SCHED;
            PG8_LDB(B0, 1, 0); PG8_LDB(B1, 1, 1); PG8_SCHED; PG8_LDA(At, 1, 0); PG8_STAGE(PG8_SA(0, 1), a2 + hstep, voffA);
            PG8_WAIT_V(8); PG8_WAIT_L(0); PG8_BAR; PG8_MMA(0, 0, At, B0); PG8_MMA(0, 1, At, B1); PG8_BAR; PG8_SCHED;
            PG8_LDA(At, 1, 1); PG8_STAGE(PG8_SB(1, 0), b3, voffB); PG8_STAGE(PG8_SB(1, 1), b3 + hstep, voffB); PG8_STAGE(PG8_SA(1, 0), a3, voffA);
            PG8_WAIT_V(8); PG8_WAIT_L(0); PG8_BAR; PG8_MMA(1, 0, At, B0); PG8_MMA(1, 1, At, B1); PG8_BAR; PG8_SCHED;
            } else {
            PG8_LDB(B0, 0, 0); PG8_SCHED; PG8_LDA(At, 0, 0); PG8_STAGE(PG8_SA(1, 1), a1 + hstep, voffA);
            PG8_WAIT_L(8); PG8_BAR; PG8_WAIT_L(0); PG8_MMA(0, 0, At, B0); PG8_BAR; PG8_SCHED;
            PG8_LDB(B1, 0, 1); PG8_STAGE(PG8_SB(0, 0), b2, voffB);
            PG8_BAR; PG8_WAIT_L(0); PG8_MMA(0, 1, At, B1); PG8_BAR;
            PG8_LDA(At, 0, 1); PG8_STAGE(PG8_SA(0, 0), a2, voffA);
            PG8_BAR; PG8_WAIT_L(0); PG8_MMA(1, 0, At, B0); PG8_BAR; PG8_SCHED;
            PG8_STAGE(PG8_SB(0, 1), b2 + hstep, voffB);
            PG8_WAIT_V(6); PG8_BAR; PG8_MMA(1, 1, At, B1); PG8_BAR;
            PG8_LDB(B0, 1, 0); PG8_SCHED; PG8_LDA(At, 1, 0); PG8_STAGE(PG8_SA(0, 1), a2 + hstep, voffA);
            PG8_WAIT_L(8); PG8_BAR; PG8_WAIT_L(0); PG8_MMA(0, 0, At, B0); PG8_BAR; PG8_SCHED;
            PG8_LDB(B1, 1, 1); PG8_STAGE(PG8_SB(1, 0), b3, voffB);
            PG8_BAR; PG8_WAIT_L(0); PG8_MMA(0, 1, At, B1); PG8_BAR;
            PG8_LDA(At, 1, 1); PG8_STAGE(PG8_SA(1, 0), a3, voffA);
            PG8_BAR; PG8_WAIT_L(0); PG8_MMA(1, 0, At, B0); PG8_BAR; PG8_SCHED;
            PG8_STAGE(PG8_SB(1, 1), b3 + hstep, voffB);
            PG8_WAIT_V(6); PG8_BAR; PG8_MMA(1, 1, At, B1); PG8_BAR;
            }
        }
        if constexpr (ALIGN_EPI) { if (wr == 0) PG8_BAR; }
        if constexpr (!Epi::AFTER_DRAIN) { E(acc, cur, wr, wc, fr, fq); S.done(cur); }
        if (!has_next) break;
#pragma unroll
        for (int a = 0; a < 2; ++a)
#pragma unroll
            for (int b = 0; b < 2; ++b)
#pragma unroll
                for (int m = 0; m < 4; ++m)
#pragma unroll
                    for (int n = 0; n < 2; ++n) acc[a][b][m][n] = (f32x4){0.f, 0.f, 0.f, 0.f};
        cur = nxt; cA = nA; cB = nB; ++ui;
        if constexpr (ALIGN_EPI) { if (wr == 1) PG8_BAR; }
    }
    PG8_WAIT_V(0);
    if constexpr (!ALIGN_EPI) { if (wr == 0) PG8_BAR; }
    PG8_BAR;
    if constexpr (Epi::AFTER_DRAIN) { E.fused(acc, cur, wr, wc, fr, fq, lds, wid, lane); S.done(cur); }
#undef PG8_SA
#undef PG8_SB
#undef PG8_STAGE
#undef PG8_LDA
#undef PG8_LDB
#undef PG8_MMA
#undef PG8_WAIT_V
#undef PG8_WAIT_L
#undef PG8_BAR
#undef PG8_SCHED
}
}
#define GAS __attribute__((address_space(1)))
#define LAS __attribute__((address_space(3)))
typedef unsigned short bf16;
typedef float f32x2v __attribute__((ext_vector_type(2)));
typedef unsigned v4u __attribute__((ext_vector_type(4)));
typedef float f32x4 __attribute__((ext_vector_type(4)));
typedef short bf16x8 __attribute__((ext_vector_type(8)));
typedef GAS unsigned gu32;
typedef GAS unsigned long long gu64;
#define RLX_AGENT __ATOMIC_RELAXED, __HIP_MEMORY_SCOPE_AGENT
#define LDS_WAIT() asm volatile("s_waitcnt lgkmcnt(0)" ::: "memory")
#define VM_WAIT() asm volatile("s_waitcnt vmcnt(0)" ::: "memory")
__device__ __forceinline__ unsigned long long rt() { return __builtin_amdgcn_s_memrealtime(); }
__device__ __forceinline__ unsigned f2bf(float f) { unsigned u = __builtin_bit_cast(unsigned, f); return (u + 0x7fffu + ((u >> 16) & 1u)) >> 16; }
__device__ __forceinline__ unsigned pk2(float lo, float hi) { return f2bf(lo) | (f2bf(hi) << 16); }

#define XB_TMO      128
#define XB_XCNT(j)  (256  + 64 * (j))
#define XB_XSUB(j)  (1280 + 64 * (j))
#define XB_XGEN(j)  (2304 + 64 * (j))
#define XB_TOP      3328
#define XB_TOPGEN   3392
#define XCD_BAR_WORDS 3456
#define XB_SPIN_CAP (1u << 18)

__device__ __forceinline__ unsigned xb_ld(unsigned* p)              { return __hip_atomic_load(p, __ATOMIC_RELAXED, __HIP_MEMORY_SCOPE_AGENT); }
__device__ __forceinline__ unsigned xb_add(unsigned* p, unsigned v) { return __hip_atomic_fetch_add(p, v, __ATOMIC_RELAXED, __HIP_MEMORY_SCOPE_AGENT); }
__device__ __forceinline__ unsigned xb_xcc_id() { return (unsigned)__builtin_amdgcn_s_getreg((3 << 11) | 20) & 0xFu; }
#define XB_SPIN(cond, bar) do { unsigned _sp = 0; while (cond) { __builtin_amdgcn_s_sleep(1); \
    if ((++_sp & 255u) == 0u) { if (xb_ld(&(bar)[XB_TMO])) break; if (_sp > XB_SPIN_CAP) { atomicAdd(&(bar)[XB_TMO], 1u); break; } } } } while (0)

struct XcdBarrier {
    unsigned* bar; unsigned x;
    volatile LAS unsigned* st;
};

__device__ __forceinline__ XcdBarrier xcd_barrier_post(unsigned* bar, volatile LAS unsigned* st) {
    XcdBarrier b; b.bar = bar; b.x = xb_xcc_id(); b.st = st;
    if (threadIdx.x == 0) (void)xb_add(&bar[XB_XCNT(b.x)], 1u);
    return b;
}
__device__ __forceinline__ void xcd_barrier_complete(unsigned* bar, unsigned x, unsigned& nloc, unsigned& nx) {
    const unsigned G = gridDim.x * gridDim.y * gridDim.z;
    unsigned sum, cnt, mine, sp = 0u;
    for (;;) {
        sum = 0u; cnt = 0u; mine = 0u;
#pragma unroll
        for (unsigned j = 0; j < 16; ++j) { const unsigned c = xb_ld(&bar[XB_XCNT(j)]); sum += c; cnt += (c > 0u) ? 1u : 0u; mine = (j == x) ? c : mine; }
        if (sum == G) break;
        __builtin_amdgcn_s_sleep(1);
        if ((++sp & 255u) == 0u) { if (xb_ld(&bar[XB_TMO])) break; if (sp > XB_SPIN_CAP) { atomicAdd(&bar[XB_TMO], 1u); break; } }
    }
    nloc = mine > 0u ? mine : 1u; nx = cnt > 0u ? cnt : 1u;
}

__device__ __forceinline__ void xcd_barrier(const XcdBarrier& b) {
    asm volatile("s_waitcnt vmcnt(0)" ::: "memory");
    __syncthreads();
    if (threadIdx.x == 0) {
        unsigned* bar = b.bar;
        __builtin_amdgcn_s_waitcnt(0);
        unsigned nloc = b.st[0], nx = b.st[1];
        if (nloc == 0u) { xcd_barrier_complete(bar, b.x, nloc, nx); b.st[0] = nloc; b.st[1] = nx; }
        const unsigned old = xb_add(&bar[XB_XSUB(b.x)], 1u);
        const unsigned gen = old / nloc;
        if (old + 1u == (gen + 1u) * nloc) {
            __builtin_amdgcn_fence(__ATOMIC_RELEASE, "agent");
            asm volatile("s_waitcnt vmcnt(0)" ::: "memory");
            const unsigned og = xb_add(&bar[XB_TOP], 1u);
            const unsigned tg = og / nx;
            if (og + 1u == (tg + 1u) * nx) xb_add(&bar[XB_TOPGEN], 1u);
            else XB_SPIN(xb_ld(&bar[XB_TOPGEN]) == tg, bar);
            __builtin_amdgcn_fence(__ATOMIC_ACQUIRE, "agent");
            xb_add(&bar[XB_XGEN(b.x)], 1u);
            asm volatile("s_waitcnt vmcnt(0)" ::: "memory");
        } else {
            XB_SPIN(xb_ld(&bar[XB_XGEN(b.x)]) == gen, bar);
            __builtin_amdgcn_fence(__ATOMIC_ACQUIRE, "agent");
            asm volatile("s_waitcnt vmcnt(0)" ::: "memory");
        }
    }
    __syncthreads();
}

constexpr int NWAVES = 8;
constexpr int BATCH = 8, SEQ = 4096, DM = 1024, M = BATCH * SEQ;
constexpr int NPROJ = 2816, NPROJ_SRC = 2824;
constexpr int FF = 4096, PLE = 256, NH = 8, HD = 64, SSD_N = 128, CONVC = 768, CHUNK = 128, NCHUNK = SEQ / CHUNK;
constexpr float EPS = 1e-6f;
constexpr float QSCALE = 0.125f * 1.4426950408889634f;

constexpr size_t MiB = 1u << 20;
constexpr size_t WS_CTL = 0, CTL_ZERO_BYTES = 1 * MiB;
constexpr size_t WS_DT = 1 * MiB;
constexpr size_t WS_TAB = 8 * MiB;
constexpr size_t WS_WIN = 16 * MiB, WS_WOUT = 22 * MiB, WS_WUP = 24 * MiB, WS_WDN = 32 * MiB, WS_WG = 40 * MiB, WS_WP = 42 * MiB;
constexpr size_t WS_XN = 48 * MiB;
constexpr size_t WS_PB = 112 * MiB;
constexpr size_t WS_H = 128 * MiB;
constexpr size_t WS_QKV = 128 * MiB;
constexpr size_t WS_Z = 224 * MiB;
constexpr size_t WS_XBC = 256 * MiB;
constexpr size_t WS_MIX = 256 * MiB;
constexpr size_t WS_PROJ = 320 * MiB;
constexpr size_t WS_XC = 384 * MiB;
constexpr size_t WS_Y = 384 * MiB;
constexpr size_t WS_CHD = 2 * MiB;
constexpr size_t WS_XT = 320 * MiB;
constexpr size_t WS_BN = 352 * MiB;
constexpr size_t WS_BT = 360 * MiB;
constexpr size_t WS_CN = 368 * MiB;
constexpr size_t WS_AO = 384 * MiB;
constexpr size_t WS_LSE = 3 * MiB;
constexpr size_t WS_ST = 128 * MiB;
constexpr size_t WS_PREV = 160 * MiB;
constexpr size_t WS_T = 384 * MiB;
constexpr size_t WS_SIG = 128 * MiB;
constexpr size_t WS_END = 512 * MiB;
constexpr int CW_TMO = 0, CW_CODE = 1, CW_BAR = 4096;

constexpr int RING_OFF = 0, RING_BYTES = 131072;
constexpr int LDSCTL_OFF = RING_BYTES, MISC_OFF = LDSCTL_OFF + 320;
constexpr int LDS_BYTES = 163840;

struct Args { const void* in[20]; float* out; unsigned char* ws; float inv_freq[32]; };
struct Frame {
    LAS unsigned char* lds;
    volatile LAS unsigned* MISC;
    gu32* ctl;
    int tid, lane, wave, vcu, G;
};
typedef unsigned v2u __attribute__((ext_vector_type(2)));
typedef short bf16x8v __attribute__((ext_vector_type(8)));
typedef float f32x16 __attribute__((ext_vector_type(16)));
__device__ __forceinline__ float bf2f(unsigned short b) { return __builtin_bit_cast(float, (unsigned)b << 16); }
__device__ __forceinline__ float bflo(unsigned w) { return __builtin_bit_cast(float, w << 16); }
__device__ __forceinline__ float bfhi(unsigned w) { return __builtin_bit_cast(float, w & 0xffff0000u); }
__device__ __forceinline__ float wave_sum(float v) {
#pragma unroll
    for (int o = 1; o < 64; o <<= 1) v += __shfl_xor(v, o);
    return v;
}
__device__ __forceinline__ float silu_f(float v) { return v / (1.0f + __expf(-v)); }

__device__ __forceinline__ void p0_transpose_item(const float* W, int K, int ldw, int ncols, bf16* WT, LAS float* scr, int item, int lane) {
    const int nblk = ncols / 32, kb = item / nblk, nb = item % nblk, k0 = 64 * kb, n0 = 32 * nb;
#pragma unroll 8
    for (int i = 0; i < 32; ++i) { const int kk = 2 * i + (lane >> 5); scr[kk * 33 + (lane & 31)] = W[(size_t)(k0 + kk) * ldw + n0 + (lane & 31)]; }
    LDS_WAIT(); asm volatile("" ::: "memory");
    const int c = lane & 7;
#pragma unroll
    for (int j = 0; j < 4; ++j) { const int n = (lane >> 3) + 8 * j; const LAS float* s = scr + (8 * c) * 33 + n;
        v4u o; o.x = pk2(s[0 * 33], s[1 * 33]); o.y = pk2(s[2 * 33], s[3 * 33]); o.z = pk2(s[4 * 33], s[5 * 33]); o.w = pk2(s[6 * 33], s[7 * 33]);
        *(GAS v4u*)(WT + (size_t)(n0 + n) * K + k0 + 8 * c) = o; }
    LDS_WAIT(); asm volatile("" ::: "memory");
}
__device__ __forceinline__ void p0_prologue(Frame& F, const Args& A) {
    unsigned char* ws = A.ws;
    LAS float* scr = (LAS float*)(F.lds + RING_OFF + F.wave * 16384);
    const int gw = F.vcu * NWAVES + F.wave, NGW = F.G * NWAVES;
    const float* w_in = (const float*)A.in[5]; const float* w_out = (const float*)A.in[12]; const float* w_up = (const float*)A.in[15];
    const float* w_dn = (const float*)A.in[16]; const float* w_g = (const float*)A.in[17]; const float* w_p = (const float*)A.in[18];
    constexpr int I_IN = (DM / 64) * (NPROJ / 32), I_OUT = (DM / 64) * (DM / 32), I_UP = (DM / 64) * (FF / 32), I_DN = (FF / 64) * (DM / 32), I_G = I_OUT, I_P = (PLE / 64) * (DM / 32);
    constexpr int NITEMS = I_IN + I_OUT + I_UP + I_DN + I_G + I_P;
    for (int it = gw; it < NITEMS; it += NGW) {
        int r = it;
        if (r < I_IN) { p0_transpose_item(w_in, DM, NPROJ_SRC, NPROJ, (bf16*)(ws + WS_WIN), scr, r, F.lane); continue; } r -= I_IN;
        if (r < I_OUT) { p0_transpose_item(w_out, DM, DM, DM, (bf16*)(ws + WS_WOUT), scr, r, F.lane); continue; } r -= I_OUT;
        if (r < I_UP) { p0_transpose_item(w_up, DM, FF, FF, (bf16*)(ws + WS_WUP), scr, r, F.lane); continue; } r -= I_UP;
        if (r < I_DN) { p0_transpose_item(w_dn, FF, DM, DM, (bf16*)(ws + WS_WDN), scr, r, F.lane); continue; } r -= I_DN;
        if (r < I_G) { p0_transpose_item(w_g, DM, DM, DM, (bf16*)(ws + WS_WG), scr, r, F.lane); continue; } r -= I_G;
        p0_transpose_item(w_p, PLE, DM, DM, (bf16*)(ws + WS_WP), scr, r, F.lane);
    }
    const float* x = (const float*)A.in[0]; const float* pin = (const float*)A.in[1]; const int* pos = (const int*)A.in[2];
    const float* g_pre = (const float*)A.in[3]; const float* dt_bias = (const float*)A.in[8];
    bf16* XN = (bf16*)(ws + WS_XN); bf16* PB = (bf16*)(ws + WS_PB); float* DT = (float*)(ws + WS_DT); float* TAB = (float*)(ws + WS_TAB);
    const int lane = F.lane;
    const float myfreq = A.inv_freq[lane & 31];
    for (int m = gw; m < M; m += NGW) {
        const GAS f32x4* xr = (const GAS f32x4*)(x + (size_t)m * DM) + lane;
        const GAS f32x4* gr = (const GAS f32x4*)g_pre + lane;
        f32x4 v[4]; float ss = 0.f;
#pragma unroll
        for (int j = 0; j < 4; ++j) { v[j] = xr[64 * j]; ss += (v[j].x * v[j].x + v[j].y * v[j].y) + (v[j].z * v[j].z + v[j].w * v[j].w); }
        const float rstd = 1.0f / sqrtf(wave_sum(ss) * (1.f / DM) + EPS);
        GAS unsigned long long* o8 = (GAS unsigned long long*)(XN + (size_t)m * DM) + lane;
        float dacc[8];
#pragma unroll
        for (int q = 0; q < 8; ++q) dacc[q] = 0.f;
#pragma unroll
        for (int j = 0; j < 4; ++j) {
            const f32x4 g = gr[64 * j]; v[j] = v[j] * rstd * g;
            o8[64 * j] = (unsigned long long)pk2(v[j].x, v[j].y) | ((unsigned long long)pk2(v[j].z, v[j].w) << 32);
#pragma unroll
            for (int e = 0; e < 4; ++e) {
                const int k = 256 * j + 4 * lane + e;
                const GAS f32x4* wp = (const GAS f32x4*)(w_in + (size_t)k * NPROJ_SRC + NPROJ);
                const f32x4 w0 = wp[0], w1 = wp[1]; const float uv = v[j][e];
                dacc[0] += uv * w0.x; dacc[1] += uv * w0.y; dacc[2] += uv * w0.z; dacc[3] += uv * w0.w;
                dacc[4] += uv * w1.x; dacc[5] += uv * w1.y; dacc[6] += uv * w1.z; dacc[7] += uv * w1.w;
            }
        }
#pragma unroll
        for (int q = 0; q < 8; ++q) dacc[q] = wave_sum(dacc[q]);
        if (lane < 8) {
            float d = dacc[0];
#pragma unroll
            for (int q = 1; q < 8; ++q) d = (lane == q) ? dacc[q] : d;
            d += dt_bias[lane];
            const float sp = d > 20.f ? d : log1pf(expf(d));
            DT[(size_t)m * 8 + lane] = sp;
        }
        if (lane < 32) {
            const float ang = (float)pos[m] * myfreq; float sn, cs; sincosf(ang, &sn, &cs);
            *(GAS f32x2v*)(TAB + ((size_t)m * 32 + lane) * 2) = (f32x2v){cs, sn};
        }
        { const f32x4 pv = *((const GAS f32x4*)(pin + (size_t)m * PLE) + lane);
          *((GAS unsigned long long*)(PB + (size_t)m * PLE) + lane) = (unsigned long long)pk2(pv.x, pv.y) | ((unsigned long long)pk2(pv.z, pv.w) << 32); }
    }
}

__device__ __forceinline__ void p_split(Frame& F, const Args& A) {
    unsigned char* ws = A.ws;
    const bf16* PROJ = (const bf16*)(ws + WS_PROJ); bf16* QKV = (bf16*)(ws + WS_QKV); bf16* Z = (bf16*)(ws + WS_Z); bf16* XBC = (bf16*)(ws + WS_XBC);
    const float* TAB = (const float*)(ws + WS_TAB);
    const long gt = (long)F.vcu * (NWAVES * 64) + F.tid, NT = (long)F.G * NWAVES * 64;
    for (long it = gt; it < (long)M * 288; it += NT) {
        const int row = (int)(it / 288), c = (int)(it % 288);
        const bf16* src = PROJ + (size_t)row * NPROJ;
        if (c < 64) {
            const int hd = c >> 2, i0 = 8 * (c & 3); const float sc = hd < 8 ? QSCALE : 1.0f;
            const v4u a = *(const GAS v4u*)(src + hd * 64 + i0), b = *(const GAS v4u*)(src + hd * 64 + 32 + i0);
            const GAS f32x4* tb = (const GAS f32x4*)(TAB + ((size_t)row * 32 + i0) * 2);
            float t1[8], t2[8], o1[8], o2[8];
            t1[0] = bflo(a.x); t1[1] = bfhi(a.x); t1[2] = bflo(a.y); t1[3] = bfhi(a.y); t1[4] = bflo(a.z); t1[5] = bfhi(a.z); t1[6] = bflo(a.w); t1[7] = bfhi(a.w);
            t2[0] = bflo(b.x); t2[1] = bfhi(b.x); t2[2] = bflo(b.y); t2[3] = bfhi(b.y); t2[4] = bflo(b.z); t2[5] = bfhi(b.z); t2[6] = bflo(b.w); t2[7] = bfhi(b.w);
#pragma unroll
            for (int e2 = 0; e2 < 4; ++e2) { const f32x4 cs = tb[e2];
                o1[2 * e2] = (t1[2 * e2] * cs.x - t2[2 * e2] * cs.y) * sc; o2[2 * e2] = (t2[2 * e2] * cs.x + t1[2 * e2] * cs.y) * sc;
                o1[2 * e2 + 1] = (t1[2 * e2 + 1] * cs.z - t2[2 * e2 + 1] * cs.w) * sc; o2[2 * e2 + 1] = (t2[2 * e2 + 1] * cs.z + t1[2 * e2 + 1] * cs.w) * sc; }
            v4u w1, w2; w1.x = pk2(o1[0], o1[1]); w1.y = pk2(o1[2], o1[3]); w1.z = pk2(o1[4], o1[5]); w1.w = pk2(o1[6], o1[7]);
            w2.x = pk2(o2[0], o2[1]); w2.y = pk2(o2[2], o2[3]); w2.z = pk2(o2[4], o2[5]); w2.w = pk2(o2[6], o2[7]);
            bf16* dst = QKV + (size_t)row * 1536 + hd * 64 + i0;
            *(GAS v4u*)dst = w1; *(GAS v4u*)(dst + 32) = w2;
        } else if (c < 128) {
            const int col = 1024 + 8 * (c - 64);
            *(GAS v4u*)(QKV + (size_t)row * 1536 + col) = *(const GAS v4u*)(src + col);
        } else if (c < 192) {
            const int cc = 8 * (c - 128); const v4u a = *(const GAS v4u*)(src + 1536 + cc); v4u w;
            w.x = pk2(silu_f(bflo(a.x)), silu_f(bfhi(a.x))); w.y = pk2(silu_f(bflo(a.y)), silu_f(bfhi(a.y)));
            w.z = pk2(silu_f(bflo(a.z)), silu_f(bfhi(a.z))); w.w = pk2(silu_f(bflo(a.w)), silu_f(bfhi(a.w)));
            *(GAS v4u*)(Z + (size_t)row * 512 + cc) = w;
        } else {
            const int cc = 8 * (c - 192);
            *(GAS v4u*)(XBC + (size_t)row * CONVC + cc) = *(const GAS v4u*)(src + 2048 + cc);
        }
    }
}

__device__ __forceinline__ void p_conv(Frame& F, const Args& A) {
    unsigned char* ws = A.ws;
    const bf16* XBC = (const bf16*)(ws + WS_XBC);
    bf16* XT = (bf16*)(ws + WS_XT); bf16* BN = (bf16*)(ws + WS_BN); bf16* BT = (bf16*)(ws + WS_BT); bf16* CN = (bf16*)(ws + WS_CN);
    const float* cw = (const float*)A.in[6]; const float* cb = (const float*)A.in[7];
    const int gw = F.vcu * NWAVES + F.wave, NGW = F.G * NWAVES, lane = F.lane;
    for (int it = gw; it < BATCH * NCHUNK * 12; it += NGW) {
        const int fg = it % 12, bc = it / 12, col = fg * 64 + lane;
        const size_t row0 = (size_t)bc * CHUNK;
        const float w0 = cw[col], w1 = cw[CONVC + col], w2 = cw[2 * CONVC + col], w3 = cw[3 * CONVC + col], bias = cb[col];
        float xm3 = 0.f, xm2 = 0.f, xm1 = 0.f;
        if ((bc & (NCHUNK - 1)) != 0) { xm3 = bf2f(XBC[(row0 - 3) * CONVC + col]); xm2 = bf2f(XBC[(row0 - 2) * CONVC + col]); xm1 = bf2f(XBC[(row0 - 1) * CONVC + col]); }
        bf16* tdst = fg < 8 ? XT + ((size_t)(bc * 8 + fg) * 64 + lane) * CHUNK : BT + ((size_t)bc * SSD_N + (fg - 8) * 64 + lane) * CHUNK;
        bf16* ndst = fg < 10 ? BN + row0 * SSD_N + (fg - 8) * 64 + lane : CN + row0 * SSD_N + (fg - 10) * 64 + lane;
        for (int t0 = 0; t0 < CHUNK; t0 += 8) {
            float xin[8], o[8];
#pragma unroll
            for (int u = 0; u < 8; ++u) xin[u] = bf2f(XBC[(row0 + t0 + u) * CONVC + col]);
#pragma unroll
            for (int u = 0; u < 8; ++u) { const float a = bias + w0 * xm3 + w1 * xm2 + w2 * xm1 + w3 * xin[u]; o[u] = silu_f(a); xm3 = xm2; xm2 = xm1; xm1 = xin[u]; }
            if (fg < 10) { v4u w; w.x = pk2(o[0], o[1]); w.y = pk2(o[2], o[3]); w.z = pk2(o[4], o[5]); w.w = pk2(o[6], o[7]); *(GAS v4u*)(tdst + t0) = w; }
            if (fg >= 8) {
#pragma unroll
                for (int u = 0; u < 8; ++u) ndst[(size_t)(t0 + u) * SSD_N] = (bf16)f2bf(o[u]); }
        }
    }
}

__device__ __forceinline__ void p_attn_naive(Frame& F, const Args& A) {
    unsigned char* ws = A.ws;
    const bf16* QKV = (const bf16*)(ws + WS_QKV); bf16* MIX = (bf16*)(ws + WS_MIX);
    const long gt = (long)F.vcu * (NWAVES * 64) + F.tid, NT = (long)F.G * NWAVES * 64;
    for (long it = gt; it < (long)M * NH; it += NT) {
        const int h = (int)(it & 7), row = (int)(it >> 3), b = row >> 12, t = row & (SEQ - 1);
        float q[64], o[64];
        { const GAS v4u* qp = (const GAS v4u*)(QKV + (size_t)row * 1536 + h * 64);
#pragma unroll
          for (int c = 0; c < 8; ++c) { const v4u a = qp[c]; q[8 * c] = bflo(a.x); q[8 * c + 1] = bfhi(a.x); q[8 * c + 2] = bflo(a.y); q[8 * c + 3] = bfhi(a.y);
              q[8 * c + 4] = bflo(a.z); q[8 * c + 5] = bfhi(a.z); q[8 * c + 6] = bflo(a.w); q[8 * c + 7] = bfhi(a.w); } }
#pragma unroll
        for (int i = 0; i < 64; ++i) o[i] = 0.f;
        float mx = -INFINITY, l = 0.f;
        for (int br = 0; br < 3; ++br) {
            const int d = br == 0 ? 1 : (br == 1 ? 4 : 16);
            for (int j = 0; j <= 128; ++j) {
                const int tk = t - d * j; if (tk < 0) break;
                const size_t krow = (size_t)(b * SEQ + tk);
                const GAS v4u* kp = (const GAS v4u*)(QKV + krow * 1536 + 512 + h * 64);
                const GAS v4u* vp = (const GAS v4u*)(QKV + krow * 1536 + 1024 + h * 64);
                float s = 0.f;
#pragma unroll
                for (int c = 0; c < 8; ++c) { const v4u a = kp[c];
                    s += q[8 * c] * bflo(a.x) + q[8 * c + 1] * bfhi(a.x) + q[8 * c + 2] * bflo(a.y) + q[8 * c + 3] * bfhi(a.y)
                       + q[8 * c + 4] * bflo(a.z) + q[8 * c + 5] * bfhi(a.z) + q[8 * c + 6] * bflo(a.w) + q[8 * c + 7] * bfhi(a.w); }
                if (s > mx) { const float f = exp2f(mx - s); l *= f;
#pragma unroll
                    for (int i = 0; i < 64; ++i) o[i] *= f;
                    mx = s; }
                const float p = exp2f(s - mx); l += p;
#pragma unroll
                for (int c = 0; c < 8; ++c) { const v4u a = vp[c];
                    o[8 * c] += p * bflo(a.x); o[8 * c + 1] += p * bfhi(a.x); o[8 * c + 2] += p * bflo(a.y); o[8 * c + 3] += p * bfhi(a.y);
                    o[8 * c + 4] += p * bflo(a.z); o[8 * c + 5] += p * bfhi(a.z); o[8 * c + 6] += p * bflo(a.w); o[8 * c + 7] += p * bfhi(a.w); }
            }
        }
        const float rl = 1.0f / l;
        GAS v4u* dst = (GAS v4u*)(MIX + (size_t)row * 1024 + h * 64);
#pragma unroll
        for (int c = 0; c < 8; ++c) { v4u w; w.x = pk2(o[8 * c] * rl, o[8 * c + 1] * rl); w.y = pk2(o[8 * c + 2] * rl, o[8 * c + 3] * rl);
            w.z = pk2(o[8 * c + 4] * rl, o[8 * c + 5] * rl); w.w = pk2(o[8 * c + 6] * rl, o[8 * c + 7] * rl); dst[c] = w; }
    }
}

constexpr int AT_K = 0, AT_V = 49152, AT_STG = 98304, AT_L = 131072 + 1024;
typedef short v4i16_t __attribute__((ext_vector_type(4)));
__device__ __forceinline__ int at_kaddr(int row, int c) { return ((row >> 1) << 8) + ((((((row & 1) << 3) | c)) ^ ((row >> 1) & 15)) << 4); }
__device__ __forceinline__ int at_vaddr(int row, int c) { return ((row >> 1) << 8) + ((((((row & 1) << 3) | c)) ^ (((row >> 1) & 1) << 2)) << 4); }
__device__ __forceinline__ void p_attn(Frame& F, const Args& A) {
    unsigned char* ws = A.ws;
    const bf16* QKV = (const bf16*)(ws + WS_QKV); bf16* AO = (bf16*)(ws + WS_AO); float* LSE = (float*)(ws + WS_LSE);
    const int lane = F.lane, w = F.wave, hi = lane >> 5, l31 = lane & 31;
    LAS unsigned char* lds = F.lds;
    LAS float* lsc = (LAS float*)(lds + AT_L) + w * 32;
    LAS unsigned short* stg = (LAS unsigned short*)(lds + AT_STG + w * 4096);
    for (int u = F.vcu; u < BATCH * NH * 48; u += F.G) {
        const int bh = u / 48, u48 = u % 48, b = bh >> 3, h = bh & 7;
        int br, d, r, qb;
        if (u48 < 16) { br = 0; d = 1; r = 0; qb = u48; } else if (u48 < 32) { br = 1; d = 4; r = (u48 - 16) >> 2; qb = (u48 - 16) & 3; } else { br = 2; d = 16; r = u48 - 32; qb = 0; }
        const size_t rowbase = (size_t)b * SEQ + r;
        const int j0 = 256 * qb - 128;
        const int minpiece = qb == 0 ? 16 : 0;
#pragma unroll
        for (int i = 0; i < 6; ++i) { const int piece = w * 6 + i;
            if (piece >= minpiece) { const int rp = piece * 4 + (lane >> 4), sl = lane & 15;
                { const int v = sl ^ (rp & 15), row = 2 * rp + (v >> 3), c = v & 7;
                  __builtin_amdgcn_global_load_lds((const unsigned*)(QKV + (rowbase + (size_t)d * (j0 + row)) * 1536 + 512 + h * 64 + c * 8), (LAS unsigned*)(lds + AT_K + piece * 1024), 16, 0, 0); }
                { const int v = sl ^ ((rp & 1) << 2), row = 2 * rp + (v >> 3), c = v & 7;
                  __builtin_amdgcn_global_load_lds((const unsigned*)(QKV + (rowbase + (size_t)d * (j0 + row)) * 1536 + 1024 + h * 64 + c * 8), (LAS unsigned*)(lds + AT_V + piece * 1024), 16, 0, 0); } } }
        const size_t qrow = rowbase + (size_t)d * (256 * qb + 32 * w + l31);
        bf16x8v qf[4];
#pragma unroll
        for (int ks = 0; ks < 4; ++ks) qf[ks] = *(const GAS bf16x8v*)(QKV + qrow * 1536 + h * 64 + 16 * ks + 8 * hi);
        asm volatile("s_waitcnt vmcnt(0)" ::: "memory"); __syncthreads();
        const int ktmin = qb == 0 ? (w < 4 ? 4 - w : 0) : 0;
        f32x16 sc[5];
#pragma unroll
        for (int kt = 0; kt < 5; ++kt) {
            sc[kt] = (f32x16){};
            if (kt >= ktmin) {
#pragma unroll
                for (int ks = 0; ks < 4; ++ks) { const bf16x8v a = *(const LAS bf16x8v*)(lds + AT_K + at_kaddr(32 * w + 32 * kt + l31, 2 * ks + hi));
                    sc[kt] = __builtin_amdgcn_mfma_f32_32x32x16_bf16(a, qf[ks], sc[kt], 0, 0, 0); } }
        }
#pragma unroll
        for (int rr = 0; rr < 16; ++rr) { const int ki = (rr & 3) + 8 * (rr >> 2) + 4 * hi;
            if (ki < l31) sc[0][rr] = -INFINITY; if (ki > l31) sc[4][rr] = -INFINITY; }
        float mx = -INFINITY;
#pragma unroll
        for (int kt = 0; kt < 5; ++kt) if (kt >= ktmin) {
#pragma unroll
            for (int rr = 0; rr < 16; ++rr) mx = fmaxf(mx, sc[kt][rr]); }
        mx = fmaxf(mx, __shfl_xor(mx, 32));
        float lsum = 0.f;
#pragma unroll
        for (int kt = 0; kt < 5; ++kt) if (kt >= ktmin) {
#pragma unroll
            for (int rr = 0; rr < 16; ++rr) { const float pv = __builtin_amdgcn_exp2f(sc[kt][rr] - mx); sc[kt][rr] = pv; lsum += pv; } }
        lsum += __shfl_xor(lsum, 32);
        f32x16 o0 = {}, o1 = {};
        const int g4 = lane >> 4, i16 = lane & 15, tq = i16 >> 2, tp = i16 & 3;
#pragma unroll
        for (int kt = 0; kt < 5; ++kt) if (kt >= ktmin) {
#pragma unroll
            for (int s2 = 0; s2 < 2; ++s2) {
                v4u po; po.x = pg8::cvt_pk_bf16(sc[kt][8 * s2 + 0], sc[kt][8 * s2 + 1]); po.y = pg8::cvt_pk_bf16(sc[kt][8 * s2 + 2], sc[kt][8 * s2 + 3]);
                po.z = pg8::cvt_pk_bf16(sc[kt][8 * s2 + 4], sc[kt][8 * s2 + 5]); po.w = pg8::cvt_pk_bf16(sc[kt][8 * s2 + 6], sc[kt][8 * s2 + 7]);
                const bf16x8v pa = __builtin_bit_cast(bf16x8v, po);
                const int R0 = 32 * w + 32 * kt + 16 * s2 + 4 * hi + tq;
#pragma unroll
                for (int dt2 = 0; dt2 < 2; ++dt2) { const int c = 2 * (g4 & 1) + 4 * dt2 + (tp >> 1);
                    const v4i16_t lo = __builtin_amdgcn_ds_read_tr16_b64_v4i16((LAS v4i16_t*)(lds + AT_V + at_vaddr(R0, c) + (tp & 1) * 8));
                    const v4i16_t hh = __builtin_amdgcn_ds_read_tr16_b64_v4i16((LAS v4i16_t*)(lds + AT_V + at_vaddr(R0 + 8, c) + (tp & 1) * 8));
                    const bf16x8v vf = (bf16x8v){lo[0], lo[1], lo[2], lo[3], hh[0], hh[1], hh[2], hh[3]};
                    if (dt2 == 0) o0 = __builtin_amdgcn_mfma_f32_32x32x16_bf16(pa, vf, o0, 0, 0, 0); else o1 = __builtin_amdgcn_mfma_f32_32x32x16_bf16(pa, vf, o1, 0, 0, 0); }
            } }
        if (hi == 0) { lsc[l31] = 1.0f / lsum; LSE[((size_t)br * M + qrow) * 8 + h] = mx + log2f(lsum); }
        asm volatile("s_waitcnt lgkmcnt(0)" ::: "memory");
#pragma unroll
        for (int q4 = 0; q4 < 4; ++q4) { const f32x4 il = *(const LAS f32x4*)(lsc + 8 * q4 + 4 * hi);
#pragma unroll
            for (int jx = 0; jx < 4; ++jx) { const int qq = 8 * q4 + 4 * hi + jx;
                stg[qq * 64 + l31] = (unsigned short)f2bf(o0[4 * q4 + jx] * il[jx]); stg[qq * 64 + 32 + l31] = (unsigned short)f2bf(o1[4 * q4 + jx] * il[jx]); } }
        asm volatile("s_waitcnt lgkmcnt(0)" ::: "memory");
#pragma unroll
        for (int i = 0; i < 4; ++i) { const int row = i * 8 + (lane >> 3), ch = lane & 7;
            const v4u val = *(const LAS v4u*)(stg + row * 64 + ch * 8);
            *(GAS v4u*)(AO + ((size_t)br * M + rowbase + (size_t)d * (256 * qb + 32 * w + row)) * 512 + h * 64 + ch * 8) = val; }
        __syncthreads();
    }
}
__device__ __forceinline__ void p_attn_merge(Frame& F, const Args& A) {
    unsigned char* ws = A.ws;
    const bf16* AO = (const bf16*)(ws + WS_AO); const float* LSE = (const float*)(ws + WS_LSE); bf16* MIX = (bf16*)(ws + WS_MIX);
    const long gt = (long)F.vcu * (NWAVES * 64) + F.tid, NT = (long)F.G * NWAVES * 64;
    for (long it = gt; it < (long)M * 64; it += NT) {
        const size_t row = (size_t)(it >> 6); const int hc = (int)(it & 63), h = hc >> 3;
        const float l0 = LSE[row * 8 + h], l1 = LSE[((size_t)M + row) * 8 + h], l2 = LSE[((size_t)2 * M + row) * 8 + h];
        const float mx = fmaxf(l0, fmaxf(l1, l2)); float w0 = exp2f(l0 - mx), w1 = exp2f(l1 - mx), w2 = exp2f(l2 - mx);
        const float inv = 1.0f / (w0 + w1 + w2); w0 *= inv; w1 *= inv; w2 *= inv;
        const v4u a = *(const GAS v4u*)(AO + row * 512 + hc * 8), bq = *(const GAS v4u*)(AO + ((size_t)M + row) * 512 + hc * 8), c = *(const GAS v4u*)(AO + ((size_t)2 * M + row) * 512 + hc * 8);
        v4u o;
        o.x = pg8::cvt_pk_bf16(w0 * bflo(a.x) + w1 * bflo(bq.x) + w2 * bflo(c.x), w0 * bfhi(a.x) + w1 * bfhi(bq.x) + w2 * bfhi(c.x));
        o.y = pg8::cvt_pk_bf16(w0 * bflo(a.y) + w1 * bflo(bq.y) + w2 * bflo(c.y), w0 * bfhi(a.y) + w1 * bfhi(bq.y) + w2 * bfhi(c.y));
        o.z = pg8::cvt_pk_bf16(w0 * bflo(a.z) + w1 * bflo(bq.z) + w2 * bflo(c.z), w0 * bfhi(a.z) + w1 * bfhi(bq.z) + w2 * bfhi(c.z));
        o.w = pg8::cvt_pk_bf16(w0 * bflo(a.w) + w1 * bflo(bq.w) + w2 * bflo(c.w), w0 * bfhi(a.w) + w1 * bfhi(bq.w) + w2 * bfhi(c.w));
        *(GAS v4u*)(MIX + row * 1024 + hc * 8) = o;
    }
}

__device__ __forceinline__ int sw256(int row, int chunk) { return row * 256 + ((chunk ^ (row & 15)) << 4); }
__device__ __forceinline__ void stage_tile128(LAS unsigned char* dst, const bf16* src, int pitch, int wave, int lane) {
#pragma unroll
    for (int i = 0; i < 4; ++i) { const int piece = wave * 4 + i, row = piece * 4 + (lane >> 4), slot = lane & 15, ch = slot ^ (row & 15);
        __builtin_amdgcn_global_load_lds((const unsigned*)(src + (size_t)row * pitch + ch * 8), (LAS unsigned*)(dst + piece * 1024), 16, 0, 0); }
}
__device__ __forceinline__ void chunk_cumsum(const float* DT, size_t row0, int h, float Ah, int lane, float& dt0, float& dt1, float& cs0, float& cs1, float& total) {
    dt0 = DT[(row0 + 2 * lane) * 8 + h]; dt1 = DT[(row0 + 2 * lane + 1) * 8 + h];
    const float a0 = dt0 * Ah, a1 = dt1 * Ah; float sc = a0 + a1;
#pragma unroll
    for (int off = 1; off < 64; off <<= 1) { const float t = __shfl_up(sc, off); if (lane >= off) sc += t; }
    cs1 = sc; cs0 = sc - a1; total = __shfl(sc, 63);
}

constexpr int S2_BT = 0, S2_WT = 32768;
__device__ __forceinline__ void p_ssd_states(Frame& F, const Args& A) {
    unsigned char* ws = A.ws;
    const bf16* XT = (const bf16*)(ws + WS_XT); const bf16* BT = (const bf16*)(ws + WS_BT); const float* DT = (const float*)(ws + WS_DT);
    bf16* ST = (bf16*)(ws + WS_ST); float* CHD = (float*)(ws + WS_CHD);
    const float* a_log = (const float*)A.in[9];
    const int lane = F.lane, h = F.wave, hi = lane >> 5, l31 = lane & 31;
    LAS unsigned char* lds = F.lds;
    LAS float* wt = (LAS float*)(lds + S2_WT) + h * CHUNK;
    for (int bc = F.vcu; bc < BATCH * NCHUNK; bc += F.G) {
        const size_t row0 = (size_t)bc * CHUNK;
        stage_tile128(lds + S2_BT, BT + (size_t)bc * SSD_N * CHUNK, CHUNK, h, lane);
        const float Ah = -expf(a_log[h]);
        float dt0, dt1, cs0, cs1, total; chunk_cumsum(DT, row0, h, Ah, lane, dt0, dt1, cs0, cs1, total);
        wt[2 * lane] = dt0 * expf(total - cs0); wt[2 * lane + 1] = dt1 * expf(total - cs1);
        if (lane == 0) CHD[bc * 8 + h] = expf(total);
        const bf16* xh = XT + (size_t)(bc * 8 + h) * 64 * CHUNK;
        v4u xr[2][8];
#pragma unroll
        for (int pt = 0; pt < 2; ++pt)
#pragma unroll
            for (int ks = 0; ks < 8; ++ks) xr[pt][ks] = *(const GAS v4u*)(xh + (size_t)(pt * 32 + l31) * CHUNK + 16 * ks + 8 * hi);
        asm volatile("s_waitcnt vmcnt(0) lgkmcnt(0)" ::: "memory"); __syncthreads();
        bf16x8v xa[2][8];
#pragma unroll
        for (int ks = 0; ks < 8; ++ks) {
            const f32x4 wa = *(const LAS f32x4*)(wt + 16 * ks + 8 * hi), wb = *(const LAS f32x4*)(wt + 16 * ks + 8 * hi + 4);
#pragma unroll
            for (int pt = 0; pt < 2; ++pt) { const v4u x = xr[pt][ks]; v4u o;
                o.x = pg8::cvt_pk_bf16(bflo(x.x) * wa.x, bfhi(x.x) * wa.y); o.y = pg8::cvt_pk_bf16(bflo(x.y) * wa.z, bfhi(x.y) * wa.w);
                o.z = pg8::cvt_pk_bf16(bflo(x.z) * wb.x, bfhi(x.z) * wb.y); o.w = pg8::cvt_pk_bf16(bflo(x.w) * wb.z, bfhi(x.w) * wb.w);
                xa[pt][ks] = __builtin_bit_cast(bf16x8v, o); }
        }
        bf16* sth = ST + (size_t)(bc * 8 + h) * 64 * SSD_N;
#pragma unroll 1
        for (int nt = 0; nt < 4; ++nt) {
            f32x16 acc0 = {}, acc1 = {};
#pragma unroll
            for (int ks = 0; ks < 8; ++ks) {
                const bf16x8v bfrag = *(const LAS bf16x8v*)(lds + S2_BT + sw256(nt * 32 + l31, 2 * ks + hi));
                acc0 = __builtin_amdgcn_mfma_f32_32x32x16_bf16(xa[0][ks], bfrag, acc0, 0, 0, 0);
                acc1 = __builtin_amdgcn_mfma_f32_32x32x16_bf16(xa[1][ks], bfrag, acc1, 0, 0, 0);
            }
#pragma unroll
            for (int r = 0; r < 16; ++r) { const int p = (r & 3) + 8 * (r >> 2) + 4 * hi;
                sth[(size_t)p * SSD_N + nt * 32 + l31] = (bf16)f2bf(acc0[r]); sth[(size_t)(32 + p) * SSD_N + nt * 32 + l31] = (bf16)f2bf(acc1[r]); }
        }
        __syncthreads();
    }
}

__device__ __forceinline__ void p_ssd_scan(Frame& F, const Args& A) {
    unsigned char* ws = A.ws;
    const bf16* ST = (const bf16*)(ws + WS_ST); bf16* PREV = (bf16*)(ws + WS_PREV); const float* CHD = (const float*)(ws + WS_CHD);
    const long gt = (long)F.vcu * (NWAVES * 64) + F.tid, NT = (long)F.G * NWAVES * 64;
    for (long e = gt; e < (long)BATCH * NH * HD * 32; e += NT) {
        const int n4 = (int)(e & 31), p = (int)(e >> 5) & 63, h = (int)(e >> 11) & 7, b = (int)(e >> 14);
        constexpr size_t CSTRIDE = (size_t)8 * 64 * SSD_N;
        const bf16* sp = ST + ((size_t)(b * NCHUNK * 8 + h) * 64 + p) * SSD_N + 4 * n4; bf16* pp = PREV + ((size_t)(b * NCHUNK * 8 + h) * 64 + p) * SSD_N + 4 * n4;
        const float* dp = CHD + (size_t)b * NCHUNK * 8 + h;
        float r0 = 0.f, r1 = 0.f, r2 = 0.f, r3 = 0.f;
#pragma unroll 1
        for (int c0 = 0; c0 < NCHUNK; c0 += 8) {
            v2u sv[8]; float dv[8];
#pragma unroll
            for (int c = 0; c < 8; ++c) { sv[c] = *(const GAS v2u*)(sp + c * CSTRIDE); dv[c] = dp[c * 8]; }
#pragma unroll
            for (int c = 0; c < 8; ++c) { v2u o; o.x = pk2(r0, r1); o.y = pk2(r2, r3); *(GAS v2u*)(pp + c * CSTRIDE) = o;
                r0 = r0 * dv[c] + bflo(sv[c].x); r1 = r1 * dv[c] + bfhi(sv[c].x); r2 = r2 * dv[c] + bflo(sv[c].y); r3 = r3 * dv[c] + bfhi(sv[c].y); }
            sp += 8 * CSTRIDE; pp += 8 * CSTRIDE; dp += 64;
        }
    }
}

constexpr int S4_CN = 0, S4_BN = 32768, S4_STG = 32768  , S4_G = 98304;
constexpr int S4_TAB = 131072 + 1024;
__device__ __forceinline__ void p_ssd_out(Frame& F, const Args& A) {
    unsigned char* ws = A.ws;
    const bf16* XT = (const bf16*)(ws + WS_XT); const bf16* BN = (const bf16*)(ws + WS_BN); const bf16* CN = (const bf16*)(ws + WS_CN); const bf16* PREV = (const bf16*)(ws + WS_PREV);
    const float* DT = (const float*)(ws + WS_DT); const bf16* Z = (const bf16*)(ws + WS_Z); bf16* MIX = (bf16*)(ws + WS_MIX);
    const float* a_log = (const float*)A.in[9]; const float* d_skip = (const float*)A.in[10]; const float* gn = (const float*)A.in[11];
    const int lane = F.lane, h = F.wave, hi = lane >> 5, l31 = lane & 31;
    LAS unsigned char* lds = F.lds;
    LAS float* cst = (LAS float*)(lds + S4_TAB) + h * CHUNK; LAS float* dtt = (LAS float*)(lds + S4_TAB + 4096) + h * CHUNK; LAS float* ect = (LAS float*)(lds + S4_TAB + 8192) + h * CHUNK;
    LAS float* rowsum = (LAS float*)(lds + S4_TAB + 12288);
    LAS float* stg = (LAS float*)(lds + S4_STG + h * 8192);
    const float Ah = -expf(a_log[h]), Dh = d_skip[h];
    for (int bc = F.vcu; bc < BATCH * NCHUNK; bc += F.G) {
        const size_t row0 = (size_t)bc * CHUNK;
        stage_tile128(lds + S4_CN, CN + row0 * SSD_N, SSD_N, h, lane);
        stage_tile128(lds + S4_BN, BN + row0 * SSD_N, SSD_N, h, lane);
        { float dt0, dt1, cs0, cs1, total; chunk_cumsum(DT, row0, h, Ah, lane, dt0, dt1, cs0, cs1, total);
          *(LAS f32x2v*)(cst + 2 * lane) = (f32x2v){cs0, cs1}; *(LAS f32x2v*)(dtt + 2 * lane) = (f32x2v){dt0, dt1}; *(LAS f32x2v*)(ect + 2 * lane) = (f32x2v){expf(cs0), expf(cs1)}; }
        const bf16* xh = XT + (size_t)(bc * 8 + h) * 64 * CHUNK; const bf16* ph = PREV + (size_t)(bc * 8 + h) * 64 * SSD_N;
        bf16x8v xb[2][8];
#pragma unroll
        for (int pt = 0; pt < 2; ++pt)
#pragma unroll
            for (int ks = 0; ks < 8; ++ks) xb[pt][ks] = *(const GAS bf16x8v*)(xh + (size_t)(pt * 32 + l31) * CHUNK + 16 * ks + 8 * hi);
        asm volatile("s_waitcnt vmcnt(0) lgkmcnt(0)" ::: "memory"); __syncthreads();
        for (int ti = h; ti < 10; ti += 8) {
            const int lt = (int)((0x3333222110ull >> (4 * ti)) & 15), st = (int)((0x3210210100ull >> (4 * ti)) & 15);
            f32x16 acc = {};
#pragma unroll
            for (int ks = 0; ks < 8; ++ks) {
                const bf16x8v a = *(const LAS bf16x8v*)(lds + S4_CN + sw256(lt * 32 + l31, 2 * ks + hi));
                const bf16x8v b = *(const LAS bf16x8v*)(lds + S4_BN + sw256(st * 32 + l31, 2 * ks + hi));
                acc = __builtin_amdgcn_mfma_f32_32x32x16_bf16(a, b, acc, 0, 0, 0);
            }
            const int scol = st * 32 + l31;
#pragma unroll
            for (int r = 0; r < 16; ++r) { const int l = lt * 32 + (r & 3) + 8 * (r >> 2) + 4 * hi;
                *(LAS unsigned short*)(lds + S4_G + sw256(l, scol >> 3) + (scol & 7) * 2) = (unsigned short)f2bf(acc[r]); }
        }
        asm volatile("s_waitcnt lgkmcnt(0)" ::: "memory"); __syncthreads();
#pragma unroll
        for (int lt = 0; lt < 4; ++lt) {
            f32x16 acc0 = {}, acc1 = {};
#pragma unroll 1
            for (int kh = 0; kh < 2; ++kh) {
                bf16x8v pf[2][4];
#pragma unroll
                for (int pt = 0; pt < 2; ++pt)
#pragma unroll
                    for (int k4 = 0; k4 < 4; ++k4) pf[pt][k4] = *(const GAS bf16x8v*)(ph + (size_t)(pt * 32 + l31) * SSD_N + 16 * (4 * kh + k4) + 8 * hi);
#pragma unroll
                for (int k4 = 0; k4 < 4; ++k4) {
                    const bf16x8v a = *(const LAS bf16x8v*)(lds + S4_CN + sw256(lt * 32 + l31, 2 * (4 * kh + k4) + hi));
                    acc0 = __builtin_amdgcn_mfma_f32_32x32x16_bf16(a, pf[0][k4], acc0, 0, 0, 0);
                    acc1 = __builtin_amdgcn_mfma_f32_32x32x16_bf16(a, pf[1][k4], acc1, 0, 0, 0);
                }
            }
#pragma unroll
            for (int q = 0; q < 4; ++q) { const f32x4 e = *(const LAS f32x4*)(ect + lt * 32 + 8 * q + 4 * hi);
#pragma unroll
                for (int j = 0; j < 4; ++j) { acc0[4 * q + j] *= e[j]; acc1[4 * q + j] *= e[j]; } }
            const int lrow = lt * 32 + l31; const float csl = cst[lrow];
#pragma unroll
            for (int st = 0; st < 4; ++st) { if (st > lt) break;
#pragma unroll
                for (int ks2 = 0; ks2 < 2; ++ks2) {
                    const int s0 = st * 32 + 16 * ks2 + 8 * hi;
                    const v4u gq = *(const LAS v4u*)(lds + S4_G + sw256(lrow, st * 4 + 2 * ks2 + hi));
                    const f32x4 ca = *(const LAS f32x4*)(cst + s0), cb = *(const LAS f32x4*)(cst + s0 + 4), da = *(const LAS f32x4*)(dtt + s0), db = *(const LAS f32x4*)(dtt + s0 + 4);
                    float m[8];
                    m[0] = bflo(gq.x) * __expf(csl - ca.x) * da.x; m[1] = bfhi(gq.x) * __expf(csl - ca.y) * da.y; m[2] = bflo(gq.y) * __expf(csl - ca.z) * da.z; m[3] = bfhi(gq.y) * __expf(csl - ca.w) * da.w;
                    m[4] = bflo(gq.z) * __expf(csl - cb.x) * db.x; m[5] = bfhi(gq.z) * __expf(csl - cb.y) * db.y; m[6] = bflo(gq.w) * __expf(csl - cb.z) * db.z; m[7] = bfhi(gq.w) * __expf(csl - cb.w) * db.w;
                    if (st == lt) {
#pragma unroll
                        for (int j = 0; j < 8; ++j) { m[j] = (s0 + j > lrow) ? 0.f : m[j]; m[j] = (s0 + j == lrow) ? m[j] + Dh : m[j]; } }
                    v4u mo; mo.x = pg8::cvt_pk_bf16(m[0], m[1]); mo.y = pg8::cvt_pk_bf16(m[2], m[3]); mo.z = pg8::cvt_pk_bf16(m[4], m[5]); mo.w = pg8::cvt_pk_bf16(m[6], m[7]);
                    const bf16x8v mf = __builtin_bit_cast(bf16x8v, mo);
                    const bf16x8v x0 = xb[0][2 * st + ks2], x1 = xb[1][2 * st + ks2];
                    acc0 = __builtin_amdgcn_mfma_f32_32x32x16_bf16(mf, x0, acc0, 0, 0, 0);
                    acc1 = __builtin_amdgcn_mfma_f32_32x32x16_bf16(mf, x1, acc1, 0, 0, 0);
                }
            }
#pragma unroll
            for (int r = 0; r < 16; ++r) { const int rr = (r & 3) + 8 * (r >> 2) + 4 * hi; stg[rr * 64 + l31] = acc0[r]; stg[rr * 64 + 32 + l31] = acc1[r]; }
            asm volatile("s_waitcnt lgkmcnt(0)" ::: "memory");
            float v[4][8];
#pragma unroll
            for (int i = 0; i < 4; ++i) { const int row = i * 8 + (lane >> 3), c0 = 8 * (lane & 7);
                const f32x4 ya = *(const LAS f32x4*)(stg + row * 64 + c0), yb = *(const LAS f32x4*)(stg + row * 64 + c0 + 4);
                const v4u zz = *(const GAS v4u*)(Z + (row0 + lt * 32 + row) * 512 + h * 64 + c0);
                v[i][0] = ya.x * bflo(zz.x); v[i][1] = ya.y * bfhi(zz.x); v[i][2] = ya.z * bflo(zz.y); v[i][3] = ya.w * bfhi(zz.y);
                v[i][4] = yb.x * bflo(zz.z); v[i][5] = yb.y * bfhi(zz.z); v[i][6] = yb.z * bflo(zz.w); v[i][7] = yb.w * bfhi(zz.w);
                float ss = 0.f;
#pragma unroll
                for (int e = 0; e < 8; ++e) ss += v[i][e] * v[i][e];
                ss += __shfl_xor(ss, 1); ss += __shfl_xor(ss, 2); ss += __shfl_xor(ss, 4);
                if ((lane & 7) == 0) rowsum[(lt * 32 + row) * 8 + h] = ss; }
            asm volatile("s_waitcnt lgkmcnt(0)" ::: "memory"); __syncthreads();
#pragma unroll
            for (int i = 0; i < 4; ++i) { const int row = i * 8 + (lane >> 3), c0 = 8 * (lane & 7);
                const f32x4 sa = *(const LAS f32x4*)(rowsum + (lt * 32 + row) * 8), sb = *(const LAS f32x4*)(rowsum + (lt * 32 + row) * 8 + 4);
                const float tot = ((sa.x + sa.y) + (sa.z + sa.w)) + ((sb.x + sb.y) + (sb.z + sb.w));
                const float rstd = 1.0f / sqrtf(tot * (1.f / 512.f) + EPS);
                const f32x4 g0 = *(const GAS f32x4*)(gn + h * 64 + c0), g1 = *(const GAS f32x4*)(gn + h * 64 + c0 + 4);
                v4u w; w.x = pg8::cvt_pk_bf16(v[i][0] * rstd * g0.x, v[i][1] * rstd * g0.y); w.y = pg8::cvt_pk_bf16(v[i][2] * rstd * g0.z, v[i][3] * rstd * g0.w);
                w.z = pg8::cvt_pk_bf16(v[i][4] * rstd * g1.x, v[i][5] * rstd * g1.y); w.w = pg8::cvt_pk_bf16(v[i][6] * rstd * g1.z, v[i][7] * rstd * g1.w);
                *(GAS v4u*)(MIX + (row0 + lt * 32 + row) * 1024 + 512 + h * 64 + c0) = w; }
        }
        __syncthreads();
    }
}

__device__ __forceinline__ void p_ssd_naive(Frame& F, const Args& A) {
    unsigned char* ws = A.ws;
    const bf16* XT = (const bf16*)(ws + WS_XT); const bf16* BN = (const bf16*)(ws + WS_BN); const bf16* CN = (const bf16*)(ws + WS_CN); const bf16* PREV = (const bf16*)(ws + WS_PREV);
    const float* DT = (const float*)(ws + WS_DT); float* Y = (float*)(ws + WS_Y);
    const float* a_log = (const float*)A.in[9]; const float* d_skip = (const float*)A.in[10];
    const int gw = F.vcu * NWAVES + F.wave, NGW = F.G * NWAVES, lane = F.lane;
    for (int it = gw; it < BATCH * NCHUNK * NH * HD; it += NGW) {
        const int bc = it >> 9, h = (it >> 6) & 7, p = it & 63;
        const float Ah = -expf(a_log[h]), Dh = d_skip[h];
        const unsigned pv = *(const GAS unsigned*)(PREV + ((size_t)(bc * 8 + h) * 64 + p) * SSD_N + 2 * lane);
        float h0 = bflo(pv), h1 = bfhi(pv);
        for (int l0 = 0; l0 < CHUNK; l0 += 8) {
            float dtv[8], xv[8]; unsigned Bv[8], Cv[8];
            const v4u xx = *(const GAS v4u*)(XT + ((size_t)(bc * 8 + h) * 64 + p) * CHUNK + l0);
            xv[0] = bflo(xx.x); xv[1] = bfhi(xx.x); xv[2] = bflo(xx.y); xv[3] = bfhi(xx.y); xv[4] = bflo(xx.z); xv[5] = bfhi(xx.z); xv[6] = bflo(xx.w); xv[7] = bfhi(xx.w);
#pragma unroll
            for (int u = 0; u < 8; ++u) { const size_t row = (size_t)bc * CHUNK + l0 + u;
                dtv[u] = DT[row * 8 + h];
                Bv[u] = *(const GAS unsigned*)(BN + row * SSD_N + 2 * lane); Cv[u] = *(const GAS unsigned*)(CN + row * SSD_N + 2 * lane); }
#pragma unroll
            for (int u = 0; u < 8; ++u) { const float dec = expf(dtv[u] * Ah), xdt = xv[u] * dtv[u];
                h0 = dec * h0 + bflo(Bv[u]) * xdt; h1 = dec * h1 + bfhi(Bv[u]) * xdt;
                const float y = wave_sum(bflo(Cv[u]) * h0 + bfhi(Cv[u]) * h1);
                if (lane == 0) Y[((size_t)bc * CHUNK + l0 + u) * 512 + h * 64 + p] = y + Dh * xv[u]; }
        }
    }
}

__device__ __forceinline__ void p_gate_naive(Frame& F, const Args& A) {
    unsigned char* ws = A.ws;
    const float* Y = (const float*)(ws + WS_Y); const bf16* Z = (const bf16*)(ws + WS_Z); bf16* MIX = (bf16*)(ws + WS_MIX);
    const float* g = (const float*)A.in[11];
    const int gw = F.vcu * NWAVES + F.wave, NGW = F.G * NWAVES, lane = F.lane;
    for (int m = gw; m < M; m += NGW) {
        const GAS f32x4* yp = (const GAS f32x4*)(Y + (size_t)m * 512 + 8 * lane); const f32x4 y0 = yp[0], y1 = yp[1];
        const v4u z = *(const GAS v4u*)(Z + (size_t)m * 512 + 8 * lane);
        float v[8]; v[0] = y0.x * bflo(z.x); v[1] = y0.y * bfhi(z.x); v[2] = y0.z * bflo(z.y); v[3] = y0.w * bfhi(z.y);
        v[4] = y1.x * bflo(z.z); v[5] = y1.y * bfhi(z.z); v[6] = y1.z * bflo(z.w); v[7] = y1.w * bfhi(z.w);
        float ss = 0.f;
#pragma unroll
        for (int e = 0; e < 8; ++e) ss += v[e] * v[e];
        const float rstd = 1.0f / sqrtf(wave_sum(ss) * (1.f / 512.f) + EPS);
        const GAS f32x4* gp = (const GAS f32x4*)(g + 8 * lane); const f32x4 g0 = gp[0], g1 = gp[1];
        v4u w; w.x = pk2(v[0] * rstd * g0.x, v[1] * rstd * g0.y); w.y = pk2(v[2] * rstd * g0.z, v[3] * rstd * g0.w);
        w.z = pk2(v[4] * rstd * g1.x, v[5] * rstd * g1.y); w.w = pk2(v[6] * rstd * g1.z, v[7] * rstd * g1.w);
        *(GAS v4u*)(MIX + (size_t)m * 1024 + 512 + 8 * lane) = w;
    }
}

template <int MODE> __device__ __forceinline__ void p_rows(Frame& F, const Args& A, const float* ga, const float* gb) {
    unsigned char* ws = A.ws;
    const float* T = (const float*)(ws + WS_T); const float* x = (const float*)A.in[0]; float* out = A.out;
    bf16* XN = (bf16*)(ws + WS_XN); const bf16* SIG = (const bf16*)(ws + WS_SIG);
    const int gw = F.vcu * NWAVES + F.wave, NGW = F.G * NWAVES, lane = F.lane;
    for (int m = gw; m < M; m += NGW) {
        const GAS f32x4* tr = (const GAS f32x4*)(T + (size_t)m * DM) + lane;
        const GAS f32x4* br = (const GAS f32x4*)((MODE == 0 ? x : (const float*)out) + (size_t)m * DM) + lane;
        GAS f32x4* orow = (GAS f32x4*)(out + (size_t)m * DM) + lane;
        f32x4 v[4], bs[4]; float ss = 0.f;
#pragma unroll
        for (int j = 0; j < 4; ++j) { v[j] = tr[64 * j]; bs[j] = br[64 * j];
            if (MODE == 2) { const v2u s = *((const GAS v2u*)(SIG + (size_t)m * DM) + lane + 64 * j); v[j].x *= bflo(s.x); v[j].y *= bfhi(s.x); v[j].z *= bflo(s.y); v[j].w *= bfhi(s.y); }
            ss += (v[j].x * v[j].x + v[j].y * v[j].y) + (v[j].z * v[j].z + v[j].w * v[j].w); }
        const float rstd = 1.0f / sqrtf(wave_sum(ss) * (1.f / DM) + EPS);
        float s2 = 0.f;
#pragma unroll
        for (int j = 0; j < 4; ++j) { const f32x4 g = *((const GAS f32x4*)ga + lane + 64 * j);
            v[j] = bs[j] + v[j] * rstd * g; orow[64 * j] = v[j];
            s2 += (v[j].x * v[j].x + v[j].y * v[j].y) + (v[j].z * v[j].z + v[j].w * v[j].w); }
        if (MODE == 0) {
            const float r2 = 1.0f / sqrtf(wave_sum(s2) * (1.f / DM) + EPS);
            GAS unsigned long long* o8 = (GAS unsigned long long*)(XN + (size_t)m * DM) + lane;
#pragma unroll
            for (int j = 0; j < 4; ++j) { const f32x4 g = *((const GAS f32x4*)gb + lane + 64 * j); const f32x4 u = v[j] * r2 * g;
                o8[64 * j] = (unsigned long long)pk2(u.x, u.y) | ((unsigned long long)pk2(u.z, u.w) << 32); }
        } else if (MODE == 1) {
            GAS unsigned long long* o8 = (GAS unsigned long long*)(XN + (size_t)m * DM) + lane;
#pragma unroll
            for (int j = 0; j < 4; ++j) o8[64 * j] = (unsigned long long)pk2(v[j].x, v[j].y) | ((unsigned long long)pk2(v[j].z, v[j].w) << 32);
        }
    }
}
template <int ACT, bool OUTBF> __device__ __forceinline__ void p_check_gemm(Frame& F, const bf16* Amat, const bf16* Bt, int K, int N, const void* C, int id) {
    const long gt = (long)F.vcu * (NWAVES * 64) + F.tid;
    unsigned hsh = (unsigned)gt * 2654435761u + 12345u * (unsigned)(id + 1);
    for (int s = 0; s < 16; ++s) {
        hsh = hsh * 1664525u + 1013904223u; const int row = (int)((hsh >> 8) % (unsigned)M);
        hsh = hsh * 1664525u + 1013904223u; const int col = (int)((hsh >> 8) % (unsigned)N);
        float acc = 0.f;
        for (int k = 0; k < K; ++k) acc += bf2f(Amat[(size_t)row * K + k]) * bf2f(Bt[(size_t)col * K + k]);
        acc = pg8::act_apply(ACT, acc);
        const float got = OUTBF ? bf2f(((const bf16*)C)[(size_t)row * N + col]) : ((const float*)C)[(size_t)row * N + col];
        const float err = fabsf(got - acc);
        if (!(err <= 0.02f * fabsf(acc) + 0.02f)) atomicAdd((unsigned*)(F.ctl + 64 + id), 1u);
    }
}

__global__ void __launch_bounds__(NWAVES * 64, 2) mk_fwd(Args args) {
    extern __shared__ __attribute__((aligned(16))) unsigned char lds[];
    Frame F;
    F.lds = (LAS unsigned char*)lds;
    F.MISC = (volatile LAS unsigned*)(F.lds + MISC_OFF);
    F.tid = threadIdx.x; F.lane = F.tid & 63; F.wave = __builtin_amdgcn_readfirstlane(F.tid >> 6);
    F.G = gridDim.x; { const int bx = blockIdx.x; F.vcu = (F.G % 8 == 0) ? (bx % 8) * (F.G / 8) + bx / 8 : bx; }
    unsigned char* ws = args.ws;
    F.ctl = (gu32*)(ws + WS_CTL);
    for (int u = F.tid; u < (LDS_BYTES - LDSCTL_OFF) / 4; u += NWAVES * 64) ((LAS unsigned*)(F.lds + LDSCTL_OFF))[u] = 0u;
    __syncthreads();
    XcdBarrier bar = xcd_barrier_post((unsigned*)(F.ctl + CW_BAR), F.MISC + 8);
#define BAR() xcd_barrier(bar)
#define GEMM_PHASE(EPI, Aoff, Boff, N_, K_, ...) do { pg8::Gemm g{(const bf16*)(ws + (Aoff)), (const bf16*)(ws + (Boff)), M, (N_), (K_)}; pg8::StaticOrder S; S.init(M, (N_), F.G, (int)blockIdx.x); \
        EPI E{__VA_ARGS__}; pg8::gemm_phase<EPI, pg8::StaticOrder, true, true>(F.lds + RING_OFF, g, S, E); } while (0)

    p0_prologue(F, args); BAR();
    GEMM_PHASE(pg8::EpiBf16<0>, WS_XN, WS_WIN, NPROJ, DM, (bf16*)(ws + WS_PROJ), NPROJ); BAR();
    p_split(F, args); BAR();
    p_conv(F, args); p_attn(F, args); BAR();
    p_ssd_states(F, args); p_attn_merge(F, args); BAR();
    p_ssd_scan(F, args); BAR();
    p_ssd_out(F, args); BAR();
    GEMM_PHASE(pg8::EpiF32, WS_MIX, WS_WOUT, DM, DM, (float*)(ws + WS_T), DM); BAR();
    p_rows<0>(F, args, (const float*)args.in[4], (const float*)args.in[13]); BAR();
    GEMM_PHASE(pg8::EpiBf16<2>, WS_XN, WS_WUP, FF, DM, (bf16*)(ws + WS_H), FF); BAR();
    GEMM_PHASE(pg8::EpiF32, WS_H, WS_WDN, DM, FF, (float*)(ws + WS_T), DM); BAR();
    p_rows<1>(F, args, (const float*)args.in[14], nullptr); BAR();
    GEMM_PHASE(pg8::EpiBf16<3>, WS_XN, WS_WG, DM, DM, (bf16*)(ws + WS_SIG), DM); BAR();
    GEMM_PHASE(pg8::EpiF32, WS_PB, WS_WP, DM, PLE, (float*)(ws + WS_T), DM); BAR();
    p_rows<2>(F, args, (const float*)args.in[19], nullptr);
#undef BAR
#undef GEMM_PHASE
}

extern "C" void kernel_launch(void* const* d_in, const int* in_sizes, int n_in, void* d_out, int out_size, void* d_ws, size_t ws_size, hipStream_t stream) {
    static int grid = 0;
    if (grid == 0) {
        if (n_in != 20 || in_sizes[0] != M * DM || out_size != M * DM || ws_size < WS_END) {
            fprintf(stderr, "kernel_launch: unexpected shapes: n_in %d in0 %d out %d ws %zu; nothing launched\n", n_in, n_in > 0 ? in_sizes[0] : -1, out_size, ws_size); grid = -1; return; }
        int dev = 0, cus = 0, per_cu = 0;
        if (hipGetDevice(&dev) != hipSuccess || hipDeviceGetAttribute(&cus, hipDeviceAttributeMultiprocessorCount, dev) != hipSuccess) { grid = -1; return; }
        if (hipFuncSetAttribute((const void*)mk_fwd, hipFuncAttributeMaxDynamicSharedMemorySize, LDS_BYTES) != hipSuccess) { fprintf(stderr, "kernel_launch: hipFuncSetAttribute failed\n"); grid = -1; return; }
        if (hipOccupancyMaxActiveBlocksPerMultiprocessor(&per_cu, (const void*)mk_fwd, NWAVES * 64, LDS_BYTES) != hipSuccess || per_cu < 1) {
            fprintf(stderr, "kernel_launch: occupancy query reports %d blocks per CU\n", per_cu); }
        (void)hipGetLastError();
        grid = cus;
    }
    if (grid < 0) return;
    (void)hipMemsetAsync((char*)d_ws + WS_CTL, 0, CTL_ZERO_BYTES, stream);
    Args a{};
    for (int i = 0; i < 20; ++i) a.in[i] = d_in[i];
    a.out = (float*)d_out; a.ws = (unsigned char*)d_ws;
    for (int i = 0; i < 32; ++i) a.inv_freq[i] = (float)pow(10000.0, -(double)i / 32.0);
    hipLaunchKernelGGL(mk_fwd, dim3(grid), dim3(NWAVES * 64), LDS_BYTES, stream, a);
}
```
